# Optimizing an MI355X kernel written in HIP

```python
import jax, jax.numpy as jnp
from jax import lax
import numpy as np

D_MODEL = 2048
BATCH = 4
SEQ = 2048
DEPTH = 1
DEC_BATCH = 128
DEC_SEQ = 1
PAST_LEN = 16384
PAGE_SIZE = 128

PLE_DIM = 256
GLA_HEADS = 4
GLA_DK = D_MODEL // 2 // GLA_HEADS
GLA_DV = D_MODEL // GLA_HEADS
GLA_RANK = 16
GLA_TAU = 16.0
RET_HEADS = 8
RET_DK = D_MODEL // RET_HEADS
RET_DV = D_MODEL // RET_HEADS
ROPE_BASE = 10000.0
CHUNK = 64
EPS = 1e-6

GLA_QK = GLA_HEADS * GLA_DK
GLA_V = GLA_HEADS * GLA_DV
RET_QK = RET_HEADS * RET_DK
RET_V = RET_HEADS * RET_DV
IN_SPLITS = (GLA_QK, GLA_QK, GLA_V, GLA_V, GLA_RANK, RET_QK, RET_QK, RET_V, RET_V, D_MODEL, D_MODEL)
N_IN = GLA_QK * 2 + GLA_V * 2 + GLA_RANK + RET_QK * 2 + RET_V * 2 + D_MODEL * 2

kernel_name = "gla_retnet_parallel_gated_decode_step"


def rmsnorm(x, g=None):
    xf = x.astype(jnp.float32)
    y = xf * lax.rsqrt(jnp.mean(xf * xf, axis=-1, keepdims=True) + EPS)
    if g is not None:
        y = y * g.astype(jnp.float32)
    return y.astype(x.dtype)


def rotary(x, pos):
    half = x.shape[-1] // 2
    inv = 1.0 / (ROPE_BASE ** jnp.linspace(0.0, 1.0, half, dtype=jnp.float32))
    ang = pos[:, None] * inv[None, :]
    cos = jnp.cos(ang)[None, :, None, :]
    sin = jnp.sin(ang)[None, :, None, :]
    xf = x.astype(jnp.float32)
    x1, x2 = xf[..., :half], xf[..., half:]
    return jnp.concatenate([x1 * cos - x2 * sin, x1 * sin + x2 * cos], axis=-1).astype(x.dtype)


def chunked_linear_recurrence(q, k, v, log_a, state):
    B, L, H, dk = q.shape
    dv = v.shape[-1]
    da = log_a.shape[-1]
    c = min(CHUNK, L)
    n = -(-L // c)
    pad = n * c - L

    def blocks(t):
        t = jnp.pad(t.astype(jnp.float32), ((0, 0), (0, pad), (0, 0), (0, 0)))
        return t.reshape(B, n, c, H, t.shape[-1]).transpose(1, 0, 3, 2, 4)

    qs, ks, vs, als = blocks(q), blocks(k), blocks(v), blocks(log_a)
    causal = jnp.tril(jnp.ones((c, c), dtype=bool))

    def step(S, blk):
        qc, kc, vc, ac = blk
        b = jnp.cumsum(ac, axis=2)
        diff = jnp.where(causal[:, :, None], b[:, :, :, None, :] - b[:, :, None, :, :], -jnp.inf)
        decay = jnp.exp(diff)
        if da == 1:
            A = jnp.einsum('bhtk,bhsk->bhts', qc, kc) * decay[..., 0]
        else:
            A = jnp.einsum('bhtk,bhsk,bhtsk->bhts', qc, kc, decay)
        o = (jnp.einsum('bhtk,bhkv->bhtv', qc * jnp.exp(b), S)
             + jnp.einsum('bhts,bhsv->bhtv', A, vc))
        b_last = b[:, :, -1:, :]
        S = (jnp.exp(b_last[:, :, 0, :, None]) * S
             + jnp.einsum('bhsk,bhsv->bhkv', kc * jnp.exp(b_last - b), vc))
        return S, o

    S, o = lax.scan(step, state.astype(jnp.float32), (qs, ks, vs, als))
    o = o.transpose(1, 0, 3, 2, 4).reshape(B, n * c, H, dv)[:, :L]
    return o.astype(v.dtype), S.astype(state.dtype)


def hybrid_layer(x, p, pos, st_gla, st_ret, norm_mix, w_in, w_gla_up, b_gla, gla_norm,
                 w_out, norm_ple, w_ple_gate, w_ple_proj):
    B, L, _ = x.shape
    u = rmsnorm(x, norm_mix)
    z = u @ w_in
    offs = np.cumsum(IN_SPLITS)[:-1].tolist()
    q_a, k_a, v_a, g_a, r_a, q_b, k_b, v_b, g_b, m_a, m_b = jnp.split(z, offs, axis=-1)

    q_a = q_a.reshape(B, L, GLA_HEADS, GLA_DK) * (GLA_DK ** -0.5)
    k_a = k_a.reshape(B, L, GLA_HEADS, GLA_DK)
    v_a = v_a.reshape(B, L, GLA_HEADS, GLA_DV)
    log_alpha = jax.nn.log_sigmoid((r_a @ w_gla_up + b_gla).astype(jnp.float32)) / GLA_TAU
    log_alpha = log_alpha.reshape(B, L, GLA_HEADS, GLA_DK)
    o_a, new_gla = chunked_linear_recurrence(q_a, k_a, v_a, log_alpha, st_gla)
    o_a = rmsnorm(o_a, gla_norm).reshape(B, L, GLA_V) * jax.nn.silu(g_a)

    q_b = rotary(q_b.reshape(B, L, RET_HEADS, RET_DK), pos)
    k_b = rotary(k_b.reshape(B, L, RET_HEADS, RET_DK), pos) * (RET_DK ** -0.5)
    v_b = v_b.reshape(B, L, RET_HEADS, RET_DV)
    log_gamma = jnp.log(1.0 - jnp.exp2(-5.0 - jnp.arange(RET_HEADS, dtype=jnp.float32)))
    log_g = jnp.broadcast_to(log_gamma[None, None, :, None], (B, L, RET_HEADS, 1))
    o_b, new_ret = chunked_linear_recurrence(q_b, k_b, v_b, log_g, st_ret)
    o_b = rmsnorm(o_b).reshape(B, L, RET_V) * jax.nn.silu(g_b)

    merged = jax.nn.sigmoid(m_a) * o_a + jax.nn.sigmoid(m_b) * o_b
    h = x + merged @ w_out

    gate = jax.nn.sigmoid(rmsnorm(h, norm_ple) @ w_ple_gate)
    h = h + gate * (p @ w_ple_proj)
    return h, new_gla, new_ret


def setup_inputs(seed: int = 0) -> dict:
    key = jax.random.key(seed)
    ks = jax.random.split(key, 16)

    def nrm(k, shape, s):
        return jax.random.normal(k, shape, jnp.float32) * s

    return {
        'x_prompt': nrm(ks[0], (BATCH, SEQ, D_MODEL), 1.0),
        'x_sample': nrm(ks[1], (DEC_BATCH, DEC_SEQ, D_MODEL), 1.0),
        'state_gla': nrm(ks[2], (DEPTH, DEC_BATCH, GLA_HEADS, GLA_DK, GLA_DV), 0.5),
        'state_ret': nrm(ks[3], (DEPTH, DEC_BATCH, RET_HEADS, RET_DK, RET_DV), 0.5),
        'p_prompt': nrm(ks[4], (DEPTH, BATCH, SEQ, PLE_DIM), 1.0),
        'p_sample': nrm(ks[5], (DEPTH, DEC_BATCH, DEC_SEQ, PLE_DIM), 1.0),
        'norm_mix': 1.0 + nrm(ks[6], (DEPTH, D_MODEL), 0.02),
        'w_in': nrm(ks[7], (DEPTH, D_MODEL, N_IN), D_MODEL ** -0.5),
        'w_gla_up': nrm(ks[8], (DEPTH, GLA_RANK, GLA_QK), GLA_RANK ** -0.5),
        'b_gla': nrm(ks[9], (DEPTH, GLA_QK), 0.1),
        'gla_norm': 1.0 + nrm(ks[10], (DEPTH, GLA_DV), 0.02),
        'w_out': nrm(ks[11], (DEPTH, D_MODEL, D_MODEL), D_MODEL ** -0.5),
        'norm_ple': 1.0 + nrm(ks[12], (DEPTH, D_MODEL), 0.02),
        'w_ple_gate': nrm(ks[13], (DEPTH, D_MODEL, D_MODEL), D_MODEL ** -0.5),
        'w_ple_proj': nrm(ks[14], (DEPTH, PLE_DIM, D_MODEL), PLE_DIM ** -0.5),
        'norm_final': 1.0 + nrm(ks[15], (D_MODEL,), 0.02),
    }


def reference(x_prompt, x_sample, state_gla, state_ret, p_prompt, p_sample, norm_mix, w_in,
              w_gla_up, b_gla, gla_norm, w_out, norm_ple, w_ple_gate, w_ple_proj, norm_final):
    Bp, Lp, _ = x_prompt.shape
    Bs, Ls, _ = x_sample.shape
    pos_prompt = jnp.arange(Lp, dtype=jnp.float32)
    pos_sample = PAST_LEN + jnp.arange(Ls, dtype=jnp.float32)
    hp, hs = x_prompt, x_sample
    gla_p, ret_p, gla_s, ret_s = [], [], [], []
    for i in range(DEPTH):
        lw = (norm_mix[i], w_in[i], w_gla_up[i], b_gla[i], gla_norm[i], w_out[i],
              norm_ple[i], w_ple_gate[i], w_ple_proj[i])
        z_gla = jnp.zeros((Bp, GLA_HEADS, GLA_DK, GLA_DV), x_prompt.dtype)
        z_ret = jnp.zeros((Bp, RET_HEADS, RET_DK, RET_DV), x_prompt.dtype)
        hp, sg, sr = hybrid_layer(hp, p_prompt[i], pos_prompt, z_gla, z_ret, *lw)
        gla_p.append(sg)
        ret_p.append(sr)
        hs, sg, sr = hybrid_layer(hs, p_sample[i], pos_sample, state_gla[i], state_ret[i], *lw)
        gla_s.append(sg)
        ret_s.append(sr)
    y_prompt = rmsnorm(hp, norm_final)
    y_sample = rmsnorm(hs, norm_final)
    return (y_prompt, y_sample, jnp.stack(gla_p), jnp.stack(ret_p), jnp.stack(gla_s), jnp.stack(ret_s))
```

```cpp
#include <hip/hip_runtime.h>
#include <cstdio>
#include <cstdint>
namespace pg8 {
#define PG8_LAS __attribute__((address_space(3)))
typedef unsigned short bf16_t;
typedef short bf16x8 __attribute__((ext_vector_type(8)));
typedef float f32x4 __attribute__((ext_vector_type(4)));
typedef unsigned u32x4 __attribute__((ext_vector_type(4)));
constexpr int BM = 256, BK = 64, HALF = 128, HTB = HALF * BK * 2  , STAGE_BYTES = 8 * HTB, NXCD = 8, WGM = 8;

__host__ __device__ __forceinline__ int lds_byte(int r, int c) { const int st = (r >> 4) * 2 + (c >> 5), rr = r & 15, cc = c & 31, ob = rr * 64 + cc * 2; return st * 1024 + (ob ^ (((ob >> 9) & 1) << 5)); }
__host__ __device__ __forceinline__ void stage_rc(int b, int& R, int& C) { const int st = b / 1024, sb = b % 1024, swz = sb ^ (((sb >> 9) & 1) << 5); R = (st >> 1) * 16 + swz / 64; C = (st & 1) * 32 + (swz % 64) / 2; }
__host__ __device__ __forceinline__ int perm32(int rho) { const int n = rho >> 4, i = rho & 15; return 8 * (i >> 2) + 4 * n + (i & 3); }

struct Unit { int pm, pn; };
struct Gemm { const bf16_t* A; const bf16_t* Bt; int M, N, K; };

struct StaticOrder {
    int nM, nN, nwg, G, c;
    __host__ __device__ void init(int M, int N, int G_, int c_) { nM = M / BM; nN = N / BM; nwg = nM * nN; G = G_; c = c_; }
    __host__ __device__ bool next(int i, Unit& u) const {
        const long L = (long)i * G + c; if (L >= nwg) return false;
        int wgid = (int)L; { const int q = nwg / NXCD, r = nwg % NXCD, xcd = wgid % NXCD, off = wgid / NXCD; wgid = (xcd < r ? xcd * (q + 1) : r * (q + 1) + (xcd - r) * q) + off; }
        const int nig = WGM * nN, gid = wgid / nig, fm = gid * WGM, gsz = (nM - fm) < WGM ? (nM - fm) : WGM;
        u.pm = fm + ((wgid % nig) % gsz); u.pn = (wgid % nig) / gsz; return true;
    }
    __device__ __forceinline__ void a_ready(const Unit&) const {}
    __device__ __forceinline__ void done(const Unit&) const {}
};
__device__ __forceinline__ unsigned cvt_pk_bf16(float lo, float hi) { unsigned r; asm volatile("v_cvt_pk_bf16_f32 %0, %1, %2" : "=v"(r) : "v"(lo), "v"(hi)); return r; }
template <class Epi, class Sched, bool ALIGN_EPI = false, bool SP2 = false>
__device__ __forceinline__ void gemm_phase(PG8_LAS unsigned char* lds, const Gemm g, const Sched& S, const Epi& E) {
    const int tid = threadIdx.x, wid = __builtin_amdgcn_readfirstlane(tid >> 6), lane = tid & 63, wr = wid >> 2, wc = wid & 3, fr = lane & 15, fq = lane >> 4;
    const int K = g.K, nt = K / BK;
    unsigned voffA[2], voffB[2];
#pragma unroll
    for (int i = 0; i < 2; ++i) { int R, C; stage_rc(tid * 16 + i * 8192, R, C); const int Rb = Epi::PERM ? ((R & ~31) + perm32(R & 31)) : R;
        voffA[i] = (unsigned)(R * K + C) * 2u; voffB[i] = (unsigned)(Rb * K + C) * 2u; }
    const size_t kstep = (size_t)(BK * 2);
    const size_t hstep = (size_t)HALF * K * 2;
    const size_t tstep = 2 * hstep;
    const unsigned ldsw = (unsigned)wid * 1024u;
    const int aoff = lds_byte(wr * 64 + fr, fq * 8), boff = lds_byte(wc * 32 + fr, fq * 8);
#define PG8_SA(b, h) (((b) * 2 + (h)) * HTB)
#define PG8_SB(b, h) ((4 + (b) * 2 + (h)) * HTB)
#define PG8_STAGE(bufoff, gbase, voff) do { _Pragma("unroll") for (int _i = 0; _i < 2; ++_i) \
        __builtin_amdgcn_global_load_lds((const unsigned*)((const char*)(gbase) + (voff)[_i]), (PG8_LAS unsigned*)(lds + (bufoff) + ldsw + _i * 8192), 16, 0, 0); } while (0)
#define PG8_LDA(dst, b, h) do { _Pragma("unroll") for (int m = 0; m < 4; ++m) _Pragma("unroll") for (int k = 0; k < 2; ++k) dst[m][k] = *(const PG8_LAS bf16x8*)(lds + PG8_SA(b, h) + aoff + m * 2048 + k * 1024); } while (0)
#define PG8_LDB(dst, b, h) do { _Pragma("unroll") for (int n = 0; n < 2; ++n) _Pragma("unroll") for (int k = 0; k < 2; ++k) dst[n][k] = *(const PG8_LAS bf16x8*)(lds + PG8_SB(b, h) + boff + n * 2048 + k * 1024); } while (0)
#define PG8_MMA(ai, bj, At, Bt) do { __builtin_amdgcn_s_setprio(1); _Pragma("unroll") for (int m = 0; m < 4; ++m) _Pragma("unroll") for (int n = 0; n < 2; ++n) _Pragma("unroll") for (int k = 0; k < 2; ++k) \
        acc[ai][bj][m][n] = __builtin_amdgcn_mfma_f32_16x16x32_bf16(Bt[n][k], At[m][k], acc[ai][bj][m][n], 0, 0, 0); __builtin_amdgcn_s_setprio(0); } while (0)
#define PG8_WAIT_V(n) asm volatile("s_waitcnt vmcnt(" #n ")" ::: "memory")
#define PG8_WAIT_L(n) asm volatile("s_waitcnt lgkmcnt(" #n ")" ::: "memory")
#define PG8_BAR __builtin_amdgcn_s_barrier()
#define PG8_SCHED __builtin_amdgcn_sched_barrier(0)
    Unit cur, nxt; int ui = 0;
    if (!S.next(0, cur)) return;
    f32x4 acc[2][2][4][2];
#pragma unroll
    for (int a = 0; a < 2; ++a)
#pragma unroll
        for (int b = 0; b < 2; ++b)
#pragma unroll
            for (int m = 0; m < 4; ++m)
#pragma unroll
                for (int n = 0; n < 2; ++n) acc[a][b][m][n] = (f32x4){0.f, 0.f, 0.f, 0.f};
    bf16x8 At[4][2], B0[2][2], B1[2][2];
    const char* cA = (const char*)g.A + (size_t)cur.pm * tstep; const char* cB = (const char*)g.Bt + (size_t)cur.pn * tstep;
    S.a_ready(cur);
    if constexpr (SP2) {
        PG8_STAGE(PG8_SB(0, 0), cB, voffB); PG8_STAGE(PG8_SB(0, 1), cB + hstep, voffB); PG8_STAGE(PG8_SA(0, 0), cA, voffA); PG8_STAGE(PG8_SA(0, 1), cA + hstep, voffA);
        if (wr == 1) PG8_BAR;
        PG8_WAIT_V(2); PG8_BAR;
        PG8_STAGE(PG8_SB(1, 0), cB + kstep, voffB); PG8_STAGE(PG8_SA(1, 0), cA + kstep, voffA); PG8_STAGE(PG8_SB(1, 1), cB + hstep + kstep, voffB);
        PG8_WAIT_V(6); PG8_BAR;
    } else {
        PG8_STAGE(PG8_SB(0, 0), cB, voffB); PG8_STAGE(PG8_SA(0, 0), cA, voffA); PG8_STAGE(PG8_SB(0, 1), cB + hstep, voffB); PG8_STAGE(PG8_SA(0, 1), cA + hstep, voffA);
        if (wr == 1) PG8_BAR;
        PG8_WAIT_V(4); PG8_BAR;
        PG8_STAGE(PG8_SB(1, 0), cB + kstep, voffB); PG8_STAGE(PG8_SA(1, 0), cA + kstep, voffA); PG8_STAGE(PG8_SB(1, 1), cB + hstep + kstep, voffB);
        PG8_WAIT_V(6); PG8_BAR;
    }
    for (;;) {
        const bool has_next = S.next(ui + 1, nxt);
        const char* nA = has_next ? (const char*)g.A + (size_t)nxt.pm * tstep : cA; const char* nB = has_next ? (const char*)g.Bt + (size_t)nxt.pn * tstep : cB;
        for (int t = 0; t < nt; t += 2) {
            const bool last = (t == nt - 2);
            const char* a1 = cA + (size_t)(t + 1) * kstep;
            const char* a2 = last ? nA : cA + (size_t)(t + 2) * kstep; const char* b2 = last ? nB : cB + (size_t)(t + 2) * kstep;
            const char* a3 = a2 + kstep; const char* b3 = b2 + kstep;
            if (last && has_next) S.a_ready(nxt);
            if constexpr (SP2) {
            PG8_LDB(B0, 0, 0); PG8_LDB(B1, 0, 1); PG8_SCHED; PG8_LDA(At, 0, 0); PG8_STAGE(PG8_SA(1, 1), a1 + hstep, voffA);
            PG8_WAIT_V(8); PG8_WAIT_L(0); PG8_BAR; PG8_MMA(0, 0, At, B0); PG8_MMA(0, 1, At, B1); PG8_BAR; PG8_SCHED;
            PG8_LDA(At, 0, 1); PG8_STAGE(PG8_SB(0, 0), b2, voffB); PG8_STAGE(PG8_SB(0, 1), b2 + hstep, voffB); PG8_STAGE(PG8_SA(0, 0), a2, voffA);
            PG8_WAIT_V(8); PG8_WAIT_L(0); PG8_BAR; PG8_MMA(1, 0, At, B0); PG8_MMA(1, 1, At, B1); PG8_BAR; PG8_SCHED;
            PG8_LDB(B0, 1, 0); PG8_LDB(B1, 1, 1); PG8_SCHED; PG8_LDA(At, 1, 0); PG8_STAGE(PG8_SA(0, 1), a2 + hstep, voffA);
            PG8_WAIT_V(8); PG8_WAIT_L(0); PG8_BAR; PG8_MMA(0, 0, At, B0); PG8_MMA(0, 1, At, B1); PG8_BAR; PG8_SCHED;
            PG8_LDA(At, 1, 1); PG8_STAGE(PG8_SB(1, 0), b3, voffB); PG8_STAGE(PG8_SB(1, 1), b3 + hstep, voffB); PG8_STAGE(PG8_SA(1, 0), a3, voffA);
            PG8_WAIT_V(8); PG8_WAIT_L(0); PG8_BAR; PG8_MMA(1, 0, At, B0); PG8_MMA(1, 1, At, B1); PG8_BAR; PG8_SCHED;
            } else {
            PG8_LDB(B0, 0, 0); PG8_SCHED; PG8_LDA(At, 0, 0); PG8_STAGE(PG8_SA(1, 1), a1 + hstep, voffA);
            PG8_WAIT_L(8); PG8_BAR; PG8_WAIT_L(0); PG8_MMA(0, 0, At, B0); PG8_BAR; PG8_SCHED;
            PG8_LDB(B1, 0, 1); PG8_STAGE(PG8_SB(0, 0), b2, voffB);
            PG8_BAR; PG8_WAIT_L(0); PG8_MMA(0, 1, At, B1); PG8_BAR;
            PG8_LDA(At, 0, 1); PG8_STAGE(PG8_SA(0, 0), a2, voffA);
            PG8_BAR; PG8_WAIT_L(0); PG8_MMA(1, 0, At, B0); PG8_BAR; PG8_SCHED;
            PG8_STAGE(PG8_SB(0, 1), b2 + hstep, voffB);
            PG8_WAIT_V(6); PG8_BAR; PG8_MMA(1, 1, At, B1); PG8_BAR;
            PG8_LDB(B0, 1, 0); PG8_SCHED; PG8_LDA(At, 1, 0); PG8_STAGE(PG8_SA(0, 1), a2 + hstep, voffA);
            PG8_WAIT_L(8); PG8_BAR; PG8_WAIT_L(0); PG8_MMA(0, 0, At, B0); PG8_BAR; PG8_SCHED;
            PG8_LDB(B1, 1, 1); PG8_STAGE(PG8_SB(1, 0), b3, voffB);
            PG8_BAR; PG8_WAIT_L(0); PG8_MMA(0, 1, At, B1); PG8_BAR;
            PG8_LDA(At, 1, 1); PG8_STAGE(PG8_SA(1, 0), a3, voffA);
            PG8_BAR; PG8_WAIT_L(0); PG8_MMA(1, 0, At, B0); PG8_BAR; PG8_SCHED;
            PG8_STAGE(PG8_SB(1, 1), b3 + hstep, voffB);
            PG8_WAIT_V(6); PG8_BAR; PG8_MMA(1, 1, At, B1); PG8_BAR;
            }
        }
        if constexpr (ALIGN_EPI) { if (wr == 0) PG8_BAR; }
        if constexpr (!Epi::AFTER_DRAIN) { E(acc, cur, wr, wc, fr, fq); S.done(cur); }
        if (!has_next) break;
#pragma unroll
        for (int a = 0; a < 2; ++a)
#pragma unroll
            for (int b = 0; b < 2; ++b)
#pragma unroll
                for (int m = 0; m < 4; ++m)
#pragma unroll
                    for (int n = 0; n < 2; ++n) acc[a][b][m][n] = (f32x4){0.f, 0.f, 0.f, 0.f};
        cur = nxt; cA = nA; cB = nB; ++ui;
        if constexpr (ALIGN_EPI) { if (wr == 1) PG8_BAR; }
    }
    PG8_WAIT_V(0);
    if constexpr (!ALIGN_EPI) { if (wr == 0) PG8_BAR; }
    PG8_BAR;
    if constexpr (Epi::AFTER_DRAIN) { E.fused(acc, cur, wr, wc, fr, fq, lds, wid, lane); S.done(cur); }
#undef PG8_SA
#undef PG8_SB
#undef PG8_STAGE
#undef PG8_LDA
#undef PG8_LDB
#undef PG8_MMA
#undef PG8_WAIT_V
#undef PG8_WAIT_L
#undef PG8_BAR
#undef PG8_SCHED
}
}
namespace pg8 {
struct EpiZ {
    static constexpr bool PERM = true, AFTER_DRAIN = false;
    bf16_t* O; int ldc;
    __device__ __forceinline__ void operator()(const f32x4 (&acc)[2][2][4][2], const Unit& u, int wr, int wc, int fr, int fq) const {
        const int row0 = u.pm * BM + wr * 64 + fr, col0 = u.pn * BM + wc * 32 + 8 * fq;
#pragma unroll
        for (int ai = 0; ai < 2; ++ai)
#pragma unroll
            for (int m = 0; m < 4; ++m) { bf16_t* rowp = O + (size_t)(row0 + ai * HALF + m * 16) * ldc + col0;
#pragma unroll
                for (int bj = 0; bj < 2; ++bj) { const f32x4 v0 = acc[ai][bj][m][0], v1 = acc[ai][bj][m][1];
                    u32x4 w; w.x = cvt_pk_bf16(v0[0], v0[1]); w.y = cvt_pk_bf16(v0[2], v0[3]); w.z = cvt_pk_bf16(v1[0], v1[1]); w.w = cvt_pk_bf16(v1[2], v1[3]);
                    *(u32x4*)(rowp + bj * HALF) = w; } }
    }
};
struct EpiResid {
    static constexpr bool PERM = false, AFTER_DRAIN = false;
    const float* xp; const float* xs; float* H;
    __device__ __forceinline__ void operator()(const f32x4 (&acc)[2][2][4][2], const Unit& u, int wr, int wc, int fr, int fq) const {
        const int row0 = u.pm * BM + wr * 64 + fr, col0 = u.pn * BM + wc * 32 + 4 * fq;
#pragma unroll
        for (int ai = 0; ai < 2; ++ai)
#pragma unroll
            for (int m = 0; m < 4; ++m) { const int r = row0 + ai * HALF + m * 16;
                const float* xr = r < 8192 ? xp + (size_t)r * 2048 : xs + (size_t)(r - 8192) * 2048; const bool real = r < 8320;
                float* hp = H + (size_t)r * 2048 + col0;
#pragma unroll
                for (int bj = 0; bj < 2; ++bj)
#pragma unroll
                    for (int n = 0; n < 2; ++n) { f32x4 xv = (f32x4){0.f, 0.f, 0.f, 0.f}; if (real) xv = *(const f32x4*)(xr + col0 + bj * HALF + n * 16);
                        *(f32x4*)(hp + bj * HALF + n * 16) = acc[ai][bj][m][n] + xv; } }
    }
};
struct EpiF32 {
    static constexpr bool PERM = false, AFTER_DRAIN = false;
    float* C;
    __device__ __forceinline__ void operator()(const f32x4 (&acc)[2][2][4][2], const Unit& u, int wr, int wc, int fr, int fq) const {
        const int row0 = u.pm * BM + wr * 64 + fr, col0 = u.pn * BM + wc * 32 + 4 * fq;
#pragma unroll
        for (int ai = 0; ai < 2; ++ai)
#pragma unroll
            for (int m = 0; m < 4; ++m) { float* cp = C + (size_t)(row0 + ai * HALF + m * 16) * 2048 + col0;
#pragma unroll
                for (int bj = 0; bj < 2; ++bj)
#pragma unroll
                    for (int n = 0; n < 2; ++n) *(f32x4*)(cp + bj * HALF + n * 16) = acc[ai][bj][m][n]; }
    }
};
struct EpiGate {
    static constexpr bool PERM = false, AFTER_DRAIN = false;
    const float* H; const float* PP; float* out;
    __device__ __forceinline__ void operator()(const f32x4 (&acc)[2][2][4][2], const Unit& u, int wr, int wc, int fr, int fq) const {
        const int row0 = u.pm * BM + wr * 64 + fr, col0 = u.pn * BM + wc * 32 + 4 * fq;
#pragma unroll
        for (int ai = 0; ai < 2; ++ai)
#pragma unroll
            for (int m = 0; m < 4; ++m) { const int r = row0 + ai * HALF + m * 16; if (r < 8320) { const size_t off = (size_t)r * 2048 + col0;
#pragma unroll
                for (int bj = 0; bj < 2; ++bj)
#pragma unroll
                    for (int n = 0; n < 2; ++n) { const f32x4 hv = *(const f32x4*)(H + off + bj * HALF + n * 16), pv = *(const f32x4*)(PP + off + bj * HALF + n * 16), a = acc[ai][bj][m][n]; f32x4 o;
#pragma unroll
                        for (int e = 0; e < 4; ++e) o[e] = hv[e] + pv[e] / (1.f + __expf(-a[e]));
                        *(f32x4*)(out + off + bj * HALF + n * 16) = o; } } }
    }
};
}
constexpr int NWAVES = 8;
#ifndef MK_N_LAUNCHES
#define MK_N_LAUNCHES 1
#endif
constexpr int N_LAUNCHES = MK_N_LAUNCHES;
constexpr int PER_PHASE = 9;
constexpr int DM = 2048, MP = 8192, MS = 128, MR = 8320, MPAD = 8448, SEQ = 2048;
constexpr int NIN = 18448, NZ = 18432, PLE = 256;
constexpr int ZQA = 0, ZKA = 1024, ZVA = 2048, ZGA = 4096, ZQB = 6144, ZKB = 8192, ZVB = 10240, ZGB = 12288, ZMA = 14336, ZMB = 16384;
constexpr int SRC_RA = 6144;
constexpr float EPS = 1e-6f;
constexpr size_t MiB = 1u << 20;
constexpr size_t WS_CTL = 0, CTL_ZERO_BYTES = 64 * 1024;
constexpr size_t WS_WIN = 1 * MiB;
constexpr size_t WS_WOUT = 73 * MiB;
constexpr size_t WS_WGATE = 81 * MiB;
constexpr size_t WS_WPP = 89 * MiB;
constexpr size_t WS_U = 90 * MiB;
constexpr size_t WS_PB = 123 * MiB;
constexpr size_t WS_RA = 128 * MiB;
constexpr size_t WS_ROPE = 129 * MiB;
constexpr size_t WS_DLAST = 132 * MiB;
constexpr size_t WS_Z = 133 * MiB;
constexpr size_t WS_OA = 430 * MiB;
constexpr size_t WS_OB = 496 * MiB;
constexpr size_t WS_MERGED = 562 * MiB;
constexpr size_t WS_H = 595 * MiB;
constexpr size_t WS_PP = 661 * MiB;
constexpr size_t WS_HN = 727 * MiB;
constexpr size_t WS_END = 760 * MiB;
static_assert(WS_Z + (size_t)MPAD * NZ * 2 <= WS_OA && WS_WIN + (size_t)NZ * DM * 2 <= WS_WOUT, "ws map");
constexpr size_t OUT_Y = 0, OUT_GLA_P = (size_t)MR * DM, OUT_RET_P = OUT_GLA_P + 2097152, OUT_GLA_S = OUT_RET_P + 2097152, OUT_RET_S = OUT_GLA_S + 67108864, OUT_END = OUT_RET_S + 67108864;
constexpr int CW_BAR = 4096;
constexpr int RING_OFF = 0, RING_BYTES = 131072;
constexpr int LDS_BYTES = 160 * 1024;
constexpr int MISC_OFF = LDS_BYTES - 256;
#define GAS __attribute__((address_space(1)))
#define LAS __attribute__((address_space(3)))
typedef unsigned short bf16;
typedef unsigned v4u __attribute__((ext_vector_type(4)));
typedef unsigned v2u __attribute__((ext_vector_type(2)));
typedef float f32x4 __attribute__((ext_vector_type(4)));
typedef short bf16x8 __attribute__((ext_vector_type(8)));
typedef GAS unsigned gu32;
#define LDS_WAIT() asm volatile("s_waitcnt lgkmcnt(0)" ::: "memory")
__device__ __forceinline__ unsigned f2bf(float f) { unsigned u = __builtin_bit_cast(unsigned, f); return (u + 0x7fffu + ((u >> 16) & 1u)) >> 16; }
__device__ __forceinline__ unsigned pk2(float lo, float hi) { return f2bf(lo) | (f2bf(hi) << 16); }
__device__ __forceinline__ float bf2f(unsigned b) { return __builtin_bit_cast(float, b << 16); }
__device__ __forceinline__ float bflo(unsigned w) { return __builtin_bit_cast(float, w << 16); }
__device__ __forceinline__ float bfhi(unsigned w) { return __builtin_bit_cast(float, w & 0xffff0000u); }
__device__ __forceinline__ float sigm(float x) { return 1.f / (1.f + __expf(-x)); }
__device__ __forceinline__ float log_sigmoid(float x) { return fminf(x, 0.f) - log1pf(expf(-fabsf(x))); }
__device__ __forceinline__ float wave_sum(float v) {
#pragma unroll
    for (int o = 1; o < 64; o <<= 1) v += __shfl_xor(v, o);
    return v;
}
#define XB_SPIN_CAP_OVERRIDE 1
#define XB_TMO      128
#define XB_XCNT(j)  (256  + 64 * (j))
#define XB_XSUB(j)  (1280 + 64 * (j))
#define XB_XGEN(j)  (2304 + 64 * (j))
#define XB_TOP      3328
#define XB_TOPGEN   3392
#define XCD_BAR_WORDS 3456
#define XB_SPIN_CAP (1u << 23)

__device__ __forceinline__ unsigned xb_ld(unsigned* p)              { return __hip_atomic_load(p, __ATOMIC_RELAXED, __HIP_MEMORY_SCOPE_AGENT); }
__device__ __forceinline__ unsigned xb_add(unsigned* p, unsigned v) { return __hip_atomic_fetch_add(p, v, __ATOMIC_RELAXED, __HIP_MEMORY_SCOPE_AGENT); }
__device__ __forceinline__ unsigned xb_xcc_id() { return (unsigned)__builtin_amdgcn_s_getreg((3 << 11) | 20) & 0xFu; }
#define XB_SPIN(cond, bar) do { unsigned _sp = 0; while (cond) { __builtin_amdgcn_s_sleep(1); \
    if ((++_sp & 255u) == 0u) { if (xb_ld(&(bar)[XB_TMO])) break; if (_sp > XB_SPIN_CAP) { atomicAdd(&(bar)[XB_TMO], 1u); break; } } } } while (0)

struct XcdBarrier {
    unsigned* bar; unsigned x;
    volatile LAS unsigned* st;
};

__device__ __forceinline__ XcdBarrier xcd_barrier_post(unsigned* bar, volatile LAS unsigned* st) {
    XcdBarrier b; b.bar = bar; b.x = xb_xcc_id(); b.st = st;
    if (threadIdx.x == 0) (void)xb_add(&bar[XB_XCNT(b.x)], 1u);
    return b;
}
__device__ __forceinline__ void xcd_barrier_complete(unsigned* bar, unsigned x, unsigned& nloc, unsigned& nx) {
    const unsigned G = gridDim.x * gridDim.y * gridDim.z;
    unsigned sum, cnt, mine, sp = 0u;
    for (;;) {
        sum = 0u; cnt = 0u; mine = 0u;
#pragma unroll
        for (unsigned j = 0; j < 16; ++j) { const unsigned c = xb_ld(&bar[XB_XCNT(j)]); sum += c; cnt += (c > 0u) ? 1u : 0u; mine = (j == x) ? c : mine; }
        if (sum == G) break;
        __builtin_amdgcn_s_sleep(1);
        if ((++sp & 255u) == 0u) { if (xb_ld(&bar[XB_TMO])) break; if (sp > XB_SPIN_CAP) { atomicAdd(&bar[XB_TMO], 1u); break; } }
    }
    nloc = mine > 0u ? mine : 1u; nx = cnt > 0u ? cnt : 1u;
}

__device__ __forceinline__ void xcd_barrier(const XcdBarrier& b) {
    asm volatile("s_waitcnt vmcnt(0)" ::: "memory");
    __syncthreads();
    if (threadIdx.x == 0) {
        unsigned* bar = b.bar;
        __builtin_amdgcn_s_waitcnt(0);
        unsigned nloc = b.st[0], nx = b.st[1];
        if (nloc == 0u) { xcd_barrier_complete(bar, b.x, nloc, nx); b.st[0] = nloc; b.st[1] = nx; }
        const unsigned old = xb_add(&bar[XB_XSUB(b.x)], 1u);
        const unsigned gen = old / nloc;
        if (old + 1u == (gen + 1u) * nloc) {
            __builtin_amdgcn_fence(__ATOMIC_RELEASE, "agent");
            asm volatile("s_waitcnt vmcnt(0)" ::: "memory");
            const unsigned og = xb_add(&bar[XB_TOP], 1u);
            const unsigned tg = og / nx;
            if (og + 1u == (tg + 1u) * nx) xb_add(&bar[XB_TOPGEN], 1u);
            else XB_SPIN(xb_ld(&bar[XB_TOPGEN]) == tg, bar);
            __builtin_amdgcn_fence(__ATOMIC_ACQUIRE, "agent");
            xb_add(&bar[XB_XGEN(b.x)], 1u);
            asm volatile("s_waitcnt vmcnt(0)" ::: "memory");
        } else {
            XB_SPIN(xb_ld(&bar[XB_XGEN(b.x)]) == gen, bar);
            __builtin_amdgcn_fence(__ATOMIC_ACQUIRE, "agent");
            asm volatile("s_waitcnt vmcnt(0)" ::: "memory");
        }
    }
    __syncthreads();
}
struct Args { const float* in[16]; float* out; unsigned char* ws; int ph_lo, ph_hi, li, pad; };
enum { I_XP = 0, I_XS, I_SGLA, I_SRET, I_PP, I_PS, I_NMIX, I_WIN, I_WUP, I_BGLA, I_GNORM, I_WOUT, I_NPLE, I_WGATE, I_WPP, I_NFIN };

__device__ __forceinline__ void p0_transpose_item(const float* W, int K, int Nsrc, int nblk, bf16* WT, LAS float* scr, int item, int lane, int gap_at) {
    const int kb = item / nblk, nb = item % nblk, k0 = 64 * kb, n0 = 32 * nb, ns = n0 + (n0 >= gap_at ? 16 : 0);
#pragma unroll 8
    for (int i = 0; i < 32; ++i) { const int kk = 2 * i + (lane >> 5); scr[kk * 33 + (lane & 31)] = W[(size_t)(k0 + kk) * Nsrc + ns + (lane & 31)]; }
    LDS_WAIT(); asm volatile("" ::: "memory");
    const int c = lane & 7;
#pragma unroll
    for (int j = 0; j < 4; ++j) { const int n = (lane >> 3) + 8 * j; const LAS float* s = scr + (8 * c) * 33 + n;
        v4u o; o.x = pk2(s[0 * 33], s[1 * 33]); o.y = pk2(s[2 * 33], s[3 * 33]); o.z = pk2(s[4 * 33], s[5 * 33]); o.w = pk2(s[6 * 33], s[7 * 33]);
        *(GAS v4u*)(WT + (size_t)(n0 + n) * K + k0 + 8 * c) = o; }
    LDS_WAIT(); asm volatile("" ::: "memory");
}
__device__ __forceinline__ const float* xrow_ptr(const Args& a, int r) { return r < MP ? a.in[I_XP] + (size_t)r * DM : a.in[I_XS] + (size_t)(r - MP) * DM; }

__device__ __forceinline__ void p0_prologue(const Args& a, LAS unsigned char* lds, int gw, int NGW, int wave, int lane) {
    unsigned char* ws = a.ws;
    LAS float* scr = (LAS float*)(lds + RING_OFF + wave * 16384);
    constexpr int I_IN = (DM / 64) * (NZ / 32), I_O = (DM / 64) * (DM / 32), I_G = I_O, I_P = (PLE / 64) * (DM / 32);
    constexpr int NITEMS = I_IN + I_O + I_G + I_P;
    for (int it = gw; it < NITEMS; it += NGW) {
        int r = it;
        if (r < I_IN) { p0_transpose_item(a.in[I_WIN], DM, NIN, NZ / 32, (bf16*)(ws + WS_WIN), scr, r, lane, SRC_RA); continue; } r -= I_IN;
        if (r < I_O) { p0_transpose_item(a.in[I_WOUT], DM, DM, DM / 32, (bf16*)(ws + WS_WOUT), scr, r, lane, 1 << 30); continue; } r -= I_O;
        if (r < I_G) { p0_transpose_item(a.in[I_WGATE], DM, DM, DM / 32, (bf16*)(ws + WS_WGATE), scr, r, lane, 1 << 30); continue; } r -= I_G;
        p0_transpose_item(a.in[I_WPP], PLE, DM, DM / 32, (bf16*)(ws + WS_WPP), scr, r, lane, 1 << 30);
    }
    {
        const float* g = a.in[I_NMIX]; const float* wr = a.in[I_WIN] + SRC_RA; bf16* U = (bf16*)(ws + WS_U); float* RA = (float*)(ws + WS_RA);
        for (int rp = gw; rp < MR / 2; rp += NGW) {
            const int r0 = 2 * rp;
            const f32x4* x0 = (const f32x4*)xrow_ptr(a, r0) + lane; const f32x4* x1 = (const f32x4*)xrow_ptr(a, r0 + 1) + lane;
            f32x4 v0[8], v1[8]; float s0 = 0.f, s1 = 0.f;
#pragma unroll
            for (int j = 0; j < 8; ++j) { v0[j] = x0[64 * j]; v1[j] = x1[64 * j];
                s0 += (v0[j].x * v0[j].x + v0[j].y * v0[j].y) + (v0[j].z * v0[j].z + v0[j].w * v0[j].w);
                s1 += (v1[j].x * v1[j].x + v1[j].y * v1[j].y) + (v1[j].z * v1[j].z + v1[j].w * v1[j].w); }
            const float rs0 = rsqrtf(wave_sum(s0) * (1.f / DM) + EPS), rs1 = rsqrtf(wave_sum(s1) * (1.f / DM) + EPS);
            float acc0[16], acc1[16];
#pragma unroll
            for (int q = 0; q < 16; ++q) { acc0[q] = 0.f; acc1[q] = 0.f; }
            unsigned long long* o0 = (unsigned long long*)(U + (size_t)r0 * DM) + lane; unsigned long long* o1 = (unsigned long long*)(U + (size_t)(r0 + 1) * DM) + lane;
#pragma unroll
            for (int j = 0; j < 8; ++j) {
                const f32x4 gv = *((const f32x4*)g + lane + 64 * j);
                f32x4 u0 = v0[j] * rs0 * gv, u1 = v1[j] * rs1 * gv;
                o0[64 * j] = (unsigned long long)pk2(u0.x, u0.y) | ((unsigned long long)pk2(u0.z, u0.w) << 32);
                o1[64 * j] = (unsigned long long)pk2(u1.x, u1.y) | ((unsigned long long)pk2(u1.z, u1.w) << 32);
#pragma unroll
                for (int e = 0; e < 4; ++e) { const int k = 256 * j + 4 * lane + e; const f32x4* wp = (const f32x4*)(wr + (size_t)k * NIN);
#pragma unroll
                    for (int q4 = 0; q4 < 4; ++q4) { const f32x4 w = wp[q4];
#pragma unroll
                        for (int t = 0; t < 4; ++t) { acc0[q4 * 4 + t] += u0[e] * w[t]; acc1[q4 * 4 + t] += u1[e] * w[t]; } } }
            }
#pragma unroll
            for (int q = 0; q < 16; ++q) { acc0[q] = wave_sum(acc0[q]); acc1[q] = wave_sum(acc1[q]); }
            if (lane < 16) { float s = 0.f, t = 0.f;
#pragma unroll
                for (int q = 0; q < 16; ++q) { s = (lane == q) ? acc0[q] : s; t = (lane == q) ? acc1[q] : t; }
                RA[(size_t)r0 * 16 + lane] = s; RA[(size_t)(r0 + 1) * 16 + lane] = t; }
        }
    }
    {
        bf16* PB = (bf16*)(ws + WS_PB); const int tid = gw * 64 + lane, NT = NGW * 64;
        for (int i = tid; i < MR * (PLE / 4); i += NT) { const int r = i / (PLE / 4), c4 = i % (PLE / 4);
            const float* src = r < MP ? a.in[I_PP] + (size_t)r * PLE : a.in[I_PS] + (size_t)(r - MP) * PLE;
            const f32x4 v = *((const f32x4*)src + c4);
            *((unsigned long long*)(PB + (size_t)r * PLE) + c4) = (unsigned long long)pk2(v.x, v.y) | ((unsigned long long)pk2(v.z, v.w) << 32); }
        float* RT = (float*)(ws + WS_ROPE);
        for (int i = tid; i < 2049 * 128; i += NT) { const int pr = i >> 7, ii = i & 127; const float pos = pr == 2048 ? 16384.f : (float)pr;
            const float e = (float)ii / 127.0f; const float inv = 1.0f / powf(10000.0f, e); const float ang = pos * inv;
            const double rev = (double)ang * 0.15915494309189533577; const float fr = (float)(rev - __builtin_rint(rev));
            RT[2 * i] = __builtin_amdgcn_cosf(fr); RT[2 * i + 1] = __builtin_amdgcn_sinf(fr); }
    }
}

__device__ __forceinline__ void p2_gate(const Args& a, int vcu, int G, int tid) {
    unsigned char* ws = a.ws; bf16* Z = (bf16*)(ws + WS_Z); const float* RA = (const float*)(ws + WS_RA); float* DL = (float*)(ws + WS_DLAST);
    const float* wup = a.in[I_WUP]; const float* bg = a.in[I_BGLA];
    for (int it = vcu; it < 256; it += G) {
        const int g = it >> 1, c = (it & 1) * 512 + tid;
        float w[16];
#pragma unroll
        for (int j = 0; j < 16; ++j) w[j] = wup[j * 1024 + c];
        const float bias = bg[c]; float bc = 0.f;
        for (int t = 0; t < 64; ++t) { const int row = g * 64 + t; const float* ra = RA + (size_t)row * 16; float x = bias;
#pragma unroll
            for (int j = 0; j < 16; ++j) x += ra[j] * w[j];
            bc += log_sigmoid(x) * (1.f / 16.f);
            bf16* zq = Z + (size_t)row * NZ + ZQA + c; bf16* zk = Z + (size_t)row * NZ + ZKA + c;
            const float q = bf2f(*zq), k = bf2f(*zk);
            *zq = (bf16)f2bf(q * 0.0625f * expf(bc)); *zk = (bf16)f2bf(k * expf(-bc)); }
        DL[(size_t)g * 1024 + c] = expf(bc);
    }
    const float* RT = (const float*)(ws + WS_ROPE);
    for (int r = vcu; r < MP; r += G) {
        const int pos = r & (SEQ - 1), t1 = (r & 63) + 1;
#pragma unroll
        for (int pp = 0; pp < 2; ++pp) { const int p = tid + 512 * pp, h = p >> 7, i = p & 127;
            const float lg = logf(1.0f - exp2f(-5.0f - (float)h)); const float dq = expf(lg * (float)t1), dk = expf(-lg * (float)t1) * 0.0625f;
            const float cs = RT[2 * (pos * 128 + i)], sn = RT[2 * (pos * 128 + i) + 1];
            bf16* q1 = Z + (size_t)r * NZ + ZQB + h * 256 + i; bf16* k1 = Z + (size_t)r * NZ + ZKB + h * 256 + i;
            const float qa = bf2f(q1[0]), qb = bf2f(q1[128]), ka = bf2f(k1[0]), kb = bf2f(k1[128]);
            q1[0] = (bf16)f2bf((qa * cs - qb * sn) * dq); q1[128] = (bf16)f2bf((qa * sn + qb * cs) * dq);
            k1[0] = (bf16)f2bf((ka * cs - kb * sn) * dk); k1[128] = (bf16)f2bf((ka * sn + kb * cs) * dk); }
    }
}

constexpr int QS_STR = 528, KT_STR = 144;
constexpr int R_QS = 0, R_KS = 33792, R_KT = 67584, R_VT = 104448, R_AS = 113664, R_ST = 122880, R_END = 156672;
static_assert(R_END <= MISC_OFF, "recurrence LDS map");
__device__ __forceinline__ bf16x8 ldfrag(const LAS unsigned char* p) { return *(const LAS bf16x8*)p; }
__device__ __forceinline__ void p3_recurrence(const Args& a, LAS unsigned char* lds, int vcu, int G, int tid, int wave, int lane) {
    unsigned char* ws = a.ws; const bf16* Z = (const bf16*)(ws + WS_Z); const float* DL = (const float*)(ws + WS_DLAST);
    const int fr = lane & 15, fq = lane >> 4;
    for (int item = vcu; item < 256; item += G) {
        const bool gla = item < 128; const int it = gla ? item : item - 128;
        const int b = it >> 5, h = gla ? (it >> 3) & 3 : (it >> 2) & 7, ds = gla ? it & 7 : it & 3;
        const int dv = gla ? 512 : 256, nh = gla ? 4 : 8;
        const int cq = (gla ? ZQA : ZQB) + h * 256, ck = (gla ? ZKA : ZKB) + h * 256, cv = (gla ? ZVA : ZVB) + h * dv + ds * 64;
        float* O = (float*)(ws + (gla ? WS_OA : WS_OB)); const int ocol = h * dv + ds * 64;
        const float lgam = logf(1.0f - exp2f(-5.0f - (float)h)); const float dret = expf(64.f * lgam);
        f32x4 sacc[2][4];
#pragma unroll
        for (int ci = 0; ci < 2; ++ci)
#pragma unroll
            for (int di = 0; di < 4; ++di) sacc[ci][di] = (f32x4){0.f, 0.f, 0.f, 0.f};
        for (int i = tid; i < 33792 / 16; i += 512) *(LAS v4u*)(lds + R_ST + i * 16) = (v4u){0u, 0u, 0u, 0u};
        for (int n = 0; n < 32; ++n) {
            const int r0 = b * SEQ + n * 64;
#pragma unroll
            for (int i = 0; i < 4; ++i) { const int p = tid + 512 * i, row = p >> 5, pc = p & 31;
                const v4u vq = *(const v4u*)(Z + (size_t)(r0 + row) * NZ + cq + pc * 8), vk = *(const v4u*)(Z + (size_t)(r0 + row) * NZ + ck + pc * 8);
                *(LAS v4u*)(lds + R_QS + row * QS_STR + pc * 16) = vq; *(LAS v4u*)(lds + R_KS + row * QS_STR + pc * 16) = vk; }
#pragma unroll
            for (int i = 0; i < 4; ++i) { const int p = tid + 512 * i, s = p & 63, pc = p >> 6;
                const v4u vk = *(const v4u*)(Z + (size_t)(r0 + s) * NZ + ck + pc * 8);
                LAS unsigned short* kt = (LAS unsigned short*)(lds + R_KT + (pc * 8) * KT_STR + s * 2);
                kt[0 * (KT_STR / 2)] = (unsigned short)vk.x; kt[1 * (KT_STR / 2)] = (unsigned short)(vk.x >> 16); kt[2 * (KT_STR / 2)] = (unsigned short)vk.y; kt[3 * (KT_STR / 2)] = (unsigned short)(vk.y >> 16);
                kt[4 * (KT_STR / 2)] = (unsigned short)vk.z; kt[5 * (KT_STR / 2)] = (unsigned short)(vk.z >> 16); kt[6 * (KT_STR / 2)] = (unsigned short)vk.w; kt[7 * (KT_STR / 2)] = (unsigned short)(vk.w >> 16); }
            { const int s = tid & 63, pc = tid >> 6;
                const v4u vv = *(const v4u*)(Z + (size_t)(r0 + s) * NZ + cv + pc * 8);
                LAS unsigned short* vt = (LAS unsigned short*)(lds + R_VT + (pc * 8) * KT_STR + s * 2);
                vt[0 * (KT_STR / 2)] = (unsigned short)vv.x; vt[1 * (KT_STR / 2)] = (unsigned short)(vv.x >> 16); vt[2 * (KT_STR / 2)] = (unsigned short)vv.y; vt[3 * (KT_STR / 2)] = (unsigned short)(vv.y >> 16);
                vt[4 * (KT_STR / 2)] = (unsigned short)vv.z; vt[5 * (KT_STR / 2)] = (unsigned short)(vv.z >> 16); vt[6 * (KT_STR / 2)] = (unsigned short)vv.w; vt[7 * (KT_STR / 2)] = (unsigned short)(vv.w >> 16); }
            __syncthreads();
            { const int ti = wave >> 1;
#pragma unroll
                for (int sj = 0; sj < 2; ++sj) { const int si = 2 * (wave & 1) + sj; f32x4 acc = (f32x4){0.f, 0.f, 0.f, 0.f};
#pragma unroll
                    for (int kk = 0; kk < 8; ++kk) { const bf16x8 af = ldfrag(lds + R_QS + (ti * 16 + fr) * QS_STR + (kk * 32 + fq * 8) * 2), bfm = ldfrag(lds + R_KS + (si * 16 + fr) * QS_STR + (kk * 32 + fq * 8) * 2);
                        acc = __builtin_amdgcn_mfma_f32_16x16x32_bf16(af, bfm, acc, 0, 0, 0); }
                    const int s = si * 16 + fr;
#pragma unroll
                    for (int e = 0; e < 4; ++e) { const int t = ti * 16 + fq * 4 + e; const float v = (s <= t) ? acc[e] : 0.f;
                        *(LAS unsigned short*)(lds + R_AS + t * KT_STR + s * 2) = (unsigned short)f2bf(v); } } }
            __syncthreads();
            { const int ti = wave >> 1;
#pragma unroll
                for (int dj = 0; dj < 2; ++dj) { const int di = 2 * (wave & 1) + dj; f32x4 acc = (f32x4){0.f, 0.f, 0.f, 0.f};
#pragma unroll
                    for (int kk = 0; kk < 8; ++kk) { const bf16x8 af = ldfrag(lds + R_QS + (ti * 16 + fr) * QS_STR + (kk * 32 + fq * 8) * 2), bfm = ldfrag(lds + R_ST + (di * 16 + fr) * QS_STR + (kk * 32 + fq * 8) * 2);
                        acc = __builtin_amdgcn_mfma_f32_16x16x32_bf16(af, bfm, acc, 0, 0, 0); }
#pragma unroll
                    for (int kk = 0; kk < 2; ++kk) { const bf16x8 af = ldfrag(lds + R_AS + (ti * 16 + fr) * KT_STR + (kk * 32 + fq * 8) * 2), bfm = ldfrag(lds + R_VT + (di * 16 + fr) * KT_STR + (kk * 32 + fq * 8) * 2);
                        acc = __builtin_amdgcn_mfma_f32_16x16x32_bf16(af, bfm, acc, 0, 0, 0); }
#pragma unroll
                    for (int e = 0; e < 4; ++e) O[(size_t)(r0 + ti * 16 + fq * 4 + e) * DM + ocol + di * 16 + fr] = acc[e]; } }
#pragma unroll
            for (int ci = 0; ci < 2; ++ci) { const int ct = 2 * wave + ci;
#pragma unroll
                for (int kk = 0; kk < 2; ++kk) { const bf16x8 af = ldfrag(lds + R_KT + (ct * 16 + fr) * KT_STR + (kk * 32 + fq * 8) * 2);
#pragma unroll
                    for (int di = 0; di < 4; ++di) { const bf16x8 bfm = ldfrag(lds + R_VT + (di * 16 + fr) * KT_STR + (kk * 32 + fq * 8) * 2);
                        sacc[ci][di] = __builtin_amdgcn_mfma_f32_16x16x32_bf16(af, bfm, sacc[ci][di], 0, 0, 0); } } }
            __syncthreads();
#pragma unroll
            for (int ci = 0; ci < 2; ++ci) { const int c0 = (2 * wave + ci) * 16 + fq * 4; f32x4 dl;
                if (gla) dl = *(const f32x4*)(DL + (size_t)(b * 32 + n) * 1024 + h * 256 + c0); else dl = (f32x4){dret, dret, dret, dret};
#pragma unroll
                for (int di = 0; di < 4; ++di) { sacc[ci][di] = sacc[ci][di] * dl; const f32x4 v = sacc[ci][di];
                    v2u w; w.x = pk2(v[0], v[1]); w.y = pk2(v[2], v[3]);
                    *(LAS v2u*)(lds + R_ST + (di * 16 + fr) * QS_STR + c0 * 2) = w; } }
            __syncthreads();
        }
        float* SO = a.out + (gla ? OUT_GLA_P : OUT_RET_P) + (size_t)(b * nh + h) * 256 * dv + ds * 64;
#pragma unroll
        for (int ci = 0; ci < 2; ++ci)
#pragma unroll
            for (int di = 0; di < 4; ++di)
#pragma unroll
                for (int e = 0; e < 4; ++e) SO[(size_t)((2 * wave + ci) * 16 + fq * 4 + e) * dv + di * 16 + fr] = sacc[ci][di][e];
    }
}

__device__ __forceinline__ void p3_decode(const Args& a, LAS unsigned char* lds, int vcu, int G, int tid) {
    unsigned char* ws = a.ws; const bf16* Z = (const bf16*)(ws + WS_Z); const float* RA = (const float*)(ws + WS_RA); const float* RT = (const float*)(ws + WS_ROPE);
    const float* sgla = a.in[I_SGLA]; const float* sret = a.in[I_SRET];
    asm volatile("" : "+s"(sgla), "+s"(sret));
    LAS float* sa = (LAS float*)lds; LAS float* sq = sa + 256; LAS float* sk = sq + 256; LAS float* red = sk + 256;
    for (int item = vcu; item < 1536; item += G) {
        const bool gla = item < 512; const int it = gla ? item : item - 512;
        const int b = gla ? it >> 2 : it >> 3, h = gla ? it & 3 : it & 7, row = MP + b;
        const bf16* zr = Z + (size_t)row * NZ;
        __syncthreads();
        if (gla) { if (tid < 256) { const int c = h * 256 + tid; float x = a.in[I_BGLA][c];
#pragma unroll
                for (int j = 0; j < 16; ++j) x += RA[(size_t)row * 16 + j] * a.in[I_WUP][j * 1024 + c];
                sa[tid] = expf(log_sigmoid(x) * (1.f / 16.f)); sq[tid] = bf2f(zr[ZQA + c]) * 0.0625f; sk[tid] = bf2f(zr[ZKA + c]); } }
        else { if (tid < 128) { const int i = tid; const float cs = RT[2 * (2048 * 128 + i)], sn = RT[2 * (2048 * 128 + i) + 1];
                const float qa = bf2f(zr[ZQB + h * 256 + i]), qb = bf2f(zr[ZQB + h * 256 + 128 + i]), ka = bf2f(zr[ZKB + h * 256 + i]), kb = bf2f(zr[ZKB + h * 256 + 128 + i]);
                sq[i] = qa * cs - qb * sn; sq[i + 128] = qa * sn + qb * cs; sk[i] = (ka * cs - kb * sn) * 0.0625f; sk[i + 128] = (ka * sn + kb * cs) * 0.0625f; } }
        __syncthreads();
        const int dv = gla ? 512 : 256, ngrp = gla ? 4 : 8, rows = gla ? 64 : 32, dg = gla ? (tid & 127) : (tid & 63), cg = gla ? (tid >> 7) : (tid >> 6);
        const float gam = 1.0f - exp2f(-5.0f - (float)h);
        const v2u vraw = *(const v2u*)(zr + (gla ? ZVA + h * 512 : ZVB + h * 256) + 4 * dg);
        const f32x4 v4 = (f32x4){bflo(vraw.x), bfhi(vraw.x), bflo(vraw.y), bfhi(vraw.y)};
        const size_t sbase = (size_t)(b * (gla ? 4 : 8) + h) * 256 * dv + 4 * dg;
        const float* Sin = (gla ? sgla : sret) + sbase; float* Sout = a.out + (gla ? OUT_GLA_S : OUT_RET_S) + sbase;
        f32x4 oacc = (f32x4){0.f, 0.f, 0.f, 0.f};
        for (int c0 = cg * rows; c0 < (cg + 1) * rows; c0 += 8) {
            f32x4 sv[8];
#pragma unroll
            for (int u = 0; u < 8; ++u) sv[u] = *(const f32x4*)(Sin + (size_t)(c0 + u) * dv);
#pragma unroll
            for (int u = 0; u < 8; ++u) { const int c = c0 + u; const float ac = gla ? sa[c] : gam; const f32x4 sn = sv[u] * ac + v4 * sk[c];
                *(f32x4*)(Sout + (size_t)c * dv) = sn; oacc += sn * sq[c]; }
        }
        *(LAS f32x4*)(red + cg * 512 + 4 * dg) = oacc;
        __syncthreads();
        if (tid < dv / 4) { f32x4 s = (f32x4){0.f, 0.f, 0.f, 0.f};
            for (int g = 0; g < ngrp; ++g) s += *(LAS f32x4*)(red + g * 512 + 4 * tid);
            *(f32x4*)((float*)(ws + (gla ? WS_OA : WS_OB)) + (size_t)row * DM + h * dv + 4 * tid) = s; }
    }
    __syncthreads();
}

__device__ __forceinline__ void p4_merge(const Args& a, int gw, int NGW, int lane) {
    unsigned char* ws = a.ws; const bf16* Z = (const bf16*)(ws + WS_Z); const float* OA = (const float*)(ws + WS_OA); const float* OB = (const float*)(ws + WS_OB); bf16* MG = (bf16*)(ws + WS_MERGED);
    const float* gn = a.in[I_GNORM];
    for (int r = gw; r < MR; r += NGW) {
        f32x4 oa[8], ob[8]; float sa2[8], sb2[8];
#pragma unroll
        for (int j = 0; j < 8; ++j) { oa[j] = *(const f32x4*)(OA + (size_t)r * DM + 256 * j + 4 * lane); ob[j] = *(const f32x4*)(OB + (size_t)r * DM + 256 * j + 4 * lane);
            sa2[j] = (oa[j].x * oa[j].x + oa[j].y * oa[j].y) + (oa[j].z * oa[j].z + oa[j].w * oa[j].w); sb2[j] = (ob[j].x * ob[j].x + ob[j].y * ob[j].y) + (ob[j].z * ob[j].z + ob[j].w * ob[j].w); }
        float ra[4], rb[8];
#pragma unroll
        for (int hh = 0; hh < 4; ++hh) ra[hh] = rsqrtf(wave_sum(sa2[2 * hh] + sa2[2 * hh + 1]) * (1.f / 512.f) + EPS);
#pragma unroll
        for (int hb = 0; hb < 8; ++hb) rb[hb] = rsqrtf(wave_sum(sb2[hb]) * (1.f / 256.f) + EPS);
        const bf16* zr = Z + (size_t)r * NZ;
#pragma unroll
        for (int j = 0; j < 8; ++j) { const int col = 256 * j + 4 * lane;
            const v2u ga = *(const v2u*)(zr + ZGA + col), gb = *(const v2u*)(zr + ZGB + col), ma = *(const v2u*)(zr + ZMA + col), mb = *(const v2u*)(zr + ZMB + col);
            const f32x4 gnv = *(const f32x4*)(gn + (col & 511));
            const float gav[4] = {bflo(ga.x), bfhi(ga.x), bflo(ga.y), bfhi(ga.y)}, gbv[4] = {bflo(gb.x), bfhi(gb.x), bflo(gb.y), bfhi(gb.y)};
            const float mav[4] = {bflo(ma.x), bfhi(ma.x), bflo(ma.y), bfhi(ma.y)}, mbv[4] = {bflo(mb.x), bfhi(mb.x), bflo(mb.y), bfhi(mb.y)};
            float o[4];
#pragma unroll
            for (int e = 0; e < 4; ++e) { const float na = oa[j][e] * ra[j >> 1] * gnv[e], nb = ob[j][e] * rb[j];
                o[e] = sigm(mav[e]) * (na * gav[e] * sigm(gav[e])) + sigm(mbv[e]) * (nb * gbv[e] * sigm(gbv[e])); }
            v2u w; w.x = pk2(o[0], o[1]); w.y = pk2(o[2], o[3]);
            *(v2u*)(MG + (size_t)r * DM + col) = w; }
    }
}
__device__ __forceinline__ void p6_norm_bf16(const float* H, const float* g, bf16* HN, int nrows, int gw, int NGW, int lane) {
    for (int r = gw; r < nrows; r += NGW) { const f32x4* x = (const f32x4*)(H + (size_t)r * DM) + lane; f32x4 v[8]; float s = 0.f;
#pragma unroll
        for (int j = 0; j < 8; ++j) { v[j] = x[64 * j]; s += (v[j].x * v[j].x + v[j].y * v[j].y) + (v[j].z * v[j].z + v[j].w * v[j].w); }
        const float rs = rsqrtf(wave_sum(s) * (1.f / DM) + EPS);
        unsigned long long* o = (unsigned long long*)(HN + (size_t)r * DM) + lane;
#pragma unroll
        for (int j = 0; j < 8; ++j) { const f32x4 gv = *((const f32x4*)g + lane + 64 * j); const f32x4 u = v[j] * rs * gv;
            o[64 * j] = (unsigned long long)pk2(u.x, u.y) | ((unsigned long long)pk2(u.z, u.w) << 32); } }
}
__device__ __forceinline__ void p8_norm_inplace(float* Y, const float* g, int nrows, int gw, int NGW, int lane) {
    for (int r = gw; r < nrows; r += NGW) { f32x4* x = (f32x4*)(Y + (size_t)r * DM) + lane; f32x4 v[8]; float s = 0.f;
#pragma unroll
        for (int j = 0; j < 8; ++j) { v[j] = x[64 * j]; s += (v[j].x * v[j].x + v[j].y * v[j].y) + (v[j].z * v[j].z + v[j].w * v[j].w); }
        const float rs = rsqrtf(wave_sum(s) * (1.f / DM) + EPS);
#pragma unroll
        for (int j = 0; j < 8; ++j) { const f32x4 gv = *((const f32x4*)g + lane + 64 * j); x[64 * j] = v[j] * rs * gv; } }
}
__global__ void __launch_bounds__(NWAVES * 64, 2) fwd_kernel(Args args) {
    extern __shared__ __attribute__((aligned(16))) unsigned char lds_raw[];
    LAS unsigned char* lds = (LAS unsigned char*)lds_raw;
    const int tid = threadIdx.x, lane = tid & 63, wave = __builtin_amdgcn_readfirstlane(tid >> 6);
    const int G = gridDim.x, bx = blockIdx.x;
    const int vcu = (G % 8 == 0) ? (bx % 8) * (G / 8) + bx / 8 : bx;
    const int gw = vcu * NWAVES + wave, NGW = G * NWAVES;
    volatile LAS unsigned* MISC = (volatile LAS unsigned*)(lds + MISC_OFF);
    if (tid < 64) MISC[tid] = 0u;
    __syncthreads();
    unsigned char* ws = args.ws;
    XcdBarrier bar; bar.bar = (unsigned*)(ws + WS_CTL) + CW_BAR; bar.x = 0; bar.st = nullptr;
    if (N_LAUNCHES == 1) bar = xcd_barrier_post((unsigned*)(ws + WS_CTL) + CW_BAR, MISC + 8);
    const int lo = args.ph_lo, hi = args.ph_hi;
#define IN(k) (lo <= (k) && (k) < hi)
#define SEAM(k) do { if (N_LAUNCHES == 1 && IN(k) && IN((k) + 1)) xcd_barrier(bar); } while (0)
    if (IN(0)) p0_prologue(args, lds, gw, NGW, wave, lane);
    SEAM(0);
    if (IN(1)) {
        pg8::Gemm g{(const pg8::bf16_t*)(ws + WS_U), (const pg8::bf16_t*)(ws + WS_WIN), MPAD, NZ, DM}; pg8::StaticOrder S; S.init(MPAD, NZ, G, bx);
        pg8::EpiZ E{(pg8::bf16_t*)(ws + WS_Z), NZ};
        pg8::gemm_phase<pg8::EpiZ, pg8::StaticOrder, true, true>(lds + RING_OFF, g, S, E);
    }
    SEAM(1);
    if (IN(2)) p2_gate(args, vcu, G, tid);
    SEAM(2);
    if (IN(3)) { p3_recurrence(args, lds, vcu, G, tid, wave, lane); p3_decode(args, lds, vcu, G, tid); }
    SEAM(3);
    if (IN(4)) p4_merge(args, gw, NGW, lane);
    SEAM(4);
    if (IN(5)) {
        { pg8::Gemm g{(const pg8::bf16_t*)(ws + WS_MERGED), (const pg8::bf16_t*)(ws + WS_WOUT), MPAD, DM, DM}; pg8::StaticOrder S; S.init(MPAD, DM, G, bx);
          pg8::EpiResid E{args.in[I_XP], args.in[I_XS], (float*)(ws + WS_H)};
          pg8::gemm_phase<pg8::EpiResid, pg8::StaticOrder, true, true>(lds + RING_OFF, g, S, E); }
        { pg8::Gemm g{(const pg8::bf16_t*)(ws + WS_PB), (const pg8::bf16_t*)(ws + WS_WPP), MPAD, DM, PLE}; pg8::StaticOrder S; S.init(MPAD, DM, G, bx);
          pg8::EpiF32 E{(float*)(ws + WS_PP)};
          pg8::gemm_phase<pg8::EpiF32, pg8::StaticOrder, true, true>(lds + RING_OFF, g, S, E); }
    }
    SEAM(5);
    if (IN(6)) p6_norm_bf16((const float*)(ws + WS_H), args.in[I_NPLE], (bf16*)(ws + WS_HN), MPAD, gw, NGW, lane);
    SEAM(6);
    if (IN(7)) {
        pg8::Gemm g{(const pg8::bf16_t*)(ws + WS_HN), (const pg8::bf16_t*)(ws + WS_WGATE), MPAD, DM, DM}; pg8::StaticOrder S; S.init(MPAD, DM, G, bx);
        pg8::EpiGate E{(const float*)(ws + WS_H), (const float*)(ws + WS_PP), args.out + OUT_Y};
        pg8::gemm_phase<pg8::EpiGate, pg8::StaticOrder, true, true>(lds + RING_OFF, g, S, E);
    }
    SEAM(7);
    if (IN(8)) p8_norm_inplace(args.out + OUT_Y, args.in[I_NFIN], MR, gw, NGW, lane);
#undef IN
#undef SEAM
}

extern "C" void kernel_launch(void* const* d_in, const int* in_sizes, int n_in, void* d_out, int out_size, void* d_ws, size_t ws_size, hipStream_t stream) {
    static int grid = 0;
    if (grid == 0) {
        if (n_in != 16 || (size_t)out_size != OUT_END || ws_size < WS_END) { fprintf(stderr, "kernel_launch: unexpected shapes: n_in %d out %d ws %zu (need out %zu ws >= %zu); nothing launched\n", n_in, out_size, ws_size, (size_t)OUT_END, (size_t)WS_END); grid = -1; return; }
        int dev = 0, cus = 0, per_cu = 0;
        if (hipGetDevice(&dev) != hipSuccess || hipDeviceGetAttribute(&cus, hipDeviceAttributeMultiprocessorCount, dev) != hipSuccess) { fprintf(stderr, "kernel_launch: device query failed\n"); grid = -1; return; }
        if (hipFuncSetAttribute((const void*)fwd_kernel, hipFuncAttributeMaxDynamicSharedMemorySize, LDS_BYTES) != hipSuccess) { fprintf(stderr, "kernel_launch: hipFuncSetAttribute(%d B LDS) failed\n", LDS_BYTES); grid = -1; return; }
        if (hipOccupancyMaxActiveBlocksPerMultiprocessor(&per_cu, (const void*)fwd_kernel, NWAVES * 64, LDS_BYTES) != hipSuccess || per_cu < 1) { fprintf(stderr, "kernel_launch: occupancy query says %d blocks/CU; nothing launched\n", per_cu); (void)hipGetLastError(); grid = -1; return; }
        grid = cus;
    }
    if (grid < 0) return;
    if (hipMemsetAsync((char*)d_ws + WS_CTL, 0, CTL_ZERO_BYTES, stream) != hipSuccess) { fprintf(stderr, "kernel_launch: memset failed\n"); return; }
    Args a{};
    for (int i = 0; i < 16; ++i) a.in[i] = (const float*)d_in[i];
    a.out = (float*)d_out; a.ws = (unsigned char*)d_ws;
    for (int li = 0; li < N_LAUNCHES; ++li) {
        a.ph_lo = (N_LAUNCHES == PER_PHASE) ? li : 0; a.ph_hi = (N_LAUNCHES == PER_PHASE) ? li + 1 : PER_PHASE; a.li = li;
        hipLaunchKernelGGL(fwd_kernel, dim3(grid), dim3(NWAVES * 64), LDS_BYTES, stream, a);
        const hipError_t le = hipPeekAtLastError();
        if (le != hipSuccess) { fprintf(stderr, "kernel_launch: launch %d failed: %s\n", li, hipGetErrorName(le)); break; }
    }
}
```

```cpp
#include <hip/hip_runtime.h>
#include <cstdio>
#include <cstdint>
namespace pg8 {
#define PG8_LAS __attribute__((address_space(3)))
typedef unsigned short bf16_t;
typedef short bf16x8 __attribute__((ext_vector_type(8)));
typedef float f32x4 __attribute__((ext_vector_type(4)));
typedef unsigned u32x4 __attribute__((ext_vector_type(4)));
constexpr int BM = 256, BK = 64, HALF = 128, HTB = HALF * BK * 2  , STAGE_BYTES = 8 * HTB, NXCD = 8, WGM = 8;

__host__ __device__ __forceinline__ int lds_byte(int r, int c) { const int st = (r >> 4) * 2 + (c >> 5), rr = r & 15, cc = c & 31, ob = rr * 64 + cc * 2; return st * 1024 + (ob ^ (((ob >> 9) & 1) << 5)); }
__host__ __device__ __forceinline__ void stage_rc(int b, int& R, int& C) { const int st = b / 1024, sb = b % 1024, swz = sb ^ (((sb >> 9) & 1) << 5); R = (st >> 1) * 16 + swz / 64; C = (st & 1) * 32 + (swz % 64) / 2; }
__host__ __device__ __forceinline__ int perm32(int rho) { const int n = rho >> 4, i = rho & 15; return 8 * (i >> 2) + 4 * n + (i & 3); }

struct Unit { int pm, pn, k0, nt, kind; };
struct Gemm { const bf16_t* A; const bf16_t* Bt; int M, N, K; };

struct StaticOrder {
    int nM, nN, nwg, G, c;
    __host__ __device__ void init(int M, int N, int G_, int c_) { nM = M / BM; nN = N / BM; nwg = nM * nN; G = G_; c = c_; }
    __host__ __device__ bool next(int i, Unit& u) const {
        const long L = (long)i * G + c; if (L >= nwg) return false;
        int wgid = (int)L; { const int q = nwg / NXCD, r = nwg % NXCD, xcd = wgid % NXCD, off = wgid / NXCD; wgid = (xcd < r ? xcd * (q + 1) : r * (q + 1) + (xcd - r) * q) + off; }
        const int nig = WGM * nN, gid = wgid / nig, fm = gid * WGM, gsz = (nM - fm) < WGM ? (nM - fm) : WGM;
        u.pm = fm + ((wgid % nig) % gsz); u.pn = (wgid % nig) / gsz; u.k0 = 0; u.nt = 0; u.kind = 0; return true;
    }
    __device__ __forceinline__ void a_ready(const Unit&) const {}
    __device__ __forceinline__ void done(const Unit&) const {}
};
struct SplitOrder {
    int nM, nN, nwg, G, c, npre, nsplit, ntk, prekind;
    __host__ __device__ void init(int nM_, int nN_, int ntk_, int nsplit_, int prekind_, int G_, int c_) { nM = nM_; nN = nN_; nwg = nM * nN; G = G_; c = c_; nsplit = nsplit_; npre = nN_ * nsplit_; ntk = ntk_; prekind = prekind_; }
    __host__ __device__ bool next(int i, Unit& u) const {
        const long L = (long)i * G + c; if (L >= npre + nwg) return false;
        if (L < npre) { const int s = (int)L; u.pm = nM; u.pn = s % nN; const int ks = s / nN; u.nt = ntk / nsplit; u.k0 = ks * u.nt; u.kind = prekind; return true; }
        int wgid = (int)(L - npre); { const int q = nwg / NXCD, r = nwg % NXCD, xcd = wgid % NXCD, off = wgid / NXCD; wgid = (xcd < r ? xcd * (q + 1) : r * (q + 1) + (xcd - r) * q) + off; }
        const int nig = WGM * nN, gid = wgid / nig, fm = gid * WGM, gsz = (nM - fm) < WGM ? (nM - fm) : WGM;
        u.pm = fm + ((wgid % nig) % gsz); u.pn = (wgid % nig) / gsz; u.k0 = 0; u.nt = ntk; u.kind = 0; return true;
    }
    __device__ __forceinline__ void a_ready(const Unit&) const {}
    __device__ __forceinline__ void done(const Unit&) const {}
};

__device__ __forceinline__ unsigned cvt_pk_bf16(float lo, float hi) { unsigned r; asm volatile("v_cvt_pk_bf16_f32 %0, %1, %2" : "=v"(r) : "v"(lo), "v"(hi)); return r; }
template <class Epi, class Sched, bool ALIGN_EPI = false, bool SP2 = false>
__device__ __forceinline__ void gemm_phase(PG8_LAS unsigned char* lds, const Gemm g, const Sched& S, const Epi& E) {
    const int tid = threadIdx.x, wid = __builtin_amdgcn_readfirstlane(tid >> 6), lane = tid & 63, wr = wid >> 2, wc = wid & 3, fr = lane & 15, fq = lane >> 4;
    const int K = g.K;
    unsigned voffA[2], voffB[2];
#pragma unroll
    for (int i = 0; i < 2; ++i) { int R, C; stage_rc(tid * 16 + i * 8192, R, C); const int Rb = Epi::PERM ? ((R & ~31) + perm32(R & 31)) : R;
        voffA[i] = (unsigned)(R * K + C) * 2u; voffB[i] = (unsigned)(Rb * K + C) * 2u; }
    const size_t kstep = (size_t)(BK * 2);
    const size_t hstep = (size_t)HALF * K * 2;
    const size_t tstep = 2 * hstep;
    const unsigned ldsw = (unsigned)wid * 1024u;
    const int aoff = lds_byte(wr * 64 + fr, fq * 8), boff = lds_byte(wc * 32 + fr, fq * 8);
#define PG8_SA(b, h) (((b) * 2 + (h)) * HTB)
#define PG8_SB(b, h) ((4 + (b) * 2 + (h)) * HTB)
#define PG8_STAGE(bufoff, gbase, voff) do { _Pragma("unroll") for (int _i = 0; _i < 2; ++_i) \
        __builtin_amdgcn_global_load_lds((const unsigned*)((const char*)(gbase) + (voff)[_i]), (PG8_LAS unsigned*)(lds + (bufoff) + ldsw + _i * 8192), 16, 0, 0); } while (0)
#define PG8_LDA(dst, b, h) do { _Pragma("unroll") for (int m = 0; m < 4; ++m) _Pragma("unroll") for (int k = 0; k < 2; ++k) dst[m][k] = *(const PG8_LAS bf16x8*)(lds + PG8_SA(b, h) + aoff + m * 2048 + k * 1024); } while (0)
#define PG8_LDB(dst, b, h) do { _Pragma("unroll") for (int n = 0; n < 2; ++n) _Pragma("unroll") for (int k = 0; k < 2; ++k) dst[n][k] = *(const PG8_LAS bf16x8*)(lds + PG8_SB(b, h) + boff + n * 2048 + k * 1024); } while (0)
#define PG8_MMA(ai, bj, At, Bt) do { __builtin_amdgcn_s_setprio(1); _Pragma("unroll") for (int m = 0; m < 4; ++m) _Pragma("unroll") for (int n = 0; n < 2; ++n) _Pragma("unroll") for (int k = 0; k < 2; ++k) \
        acc[ai][bj][m][n] = __builtin_amdgcn_mfma_f32_16x16x32_bf16(Bt[n][k], At[m][k], acc[ai][bj][m][n], 0, 0, 0); __builtin_amdgcn_s_setprio(0); } while (0)
#define PG8_WAIT_V(n) asm volatile("s_waitcnt vmcnt(" #n ")" ::: "memory")
#define PG8_WAIT_L(n) asm volatile("s_waitcnt lgkmcnt(" #n ")" ::: "memory")
#define PG8_BAR __builtin_amdgcn_s_barrier()
#define PG8_SCHED __builtin_amdgcn_sched_barrier(0)
    Unit cur, nxt; int ui = 0;
    if (!S.next(0, cur)) return;
    f32x4 acc[2][2][4][2];
#pragma unroll
    for (int a = 0; a < 2; ++a)
#pragma unroll
        for (int b = 0; b < 2; ++b)
#pragma unroll
            for (int m = 0; m < 4; ++m)
#pragma unroll
                for (int n = 0; n < 2; ++n) acc[a][b][m][n] = (f32x4){0.f, 0.f, 0.f, 0.f};
    bf16x8 At[4][2], B0[2][2], B1[2][2];
    const char* cA = (const char*)g.A + (size_t)cur.pm * tstep + (size_t)cur.k0 * kstep; const char* cB = (const char*)g.Bt + (size_t)cur.pn * tstep + (size_t)cur.k0 * kstep;
    S.a_ready(cur);
    if constexpr (SP2) {
        PG8_STAGE(PG8_SB(0, 0), cB, voffB); PG8_STAGE(PG8_SB(0, 1), cB + hstep, voffB); PG8_STAGE(PG8_SA(0, 0), cA, voffA); PG8_STAGE(PG8_SA(0, 1), cA + hstep, voffA);
        if (wr == 1) PG8_BAR;
        PG8_WAIT_V(2); PG8_BAR;
        PG8_STAGE(PG8_SB(1, 0), cB + kstep, voffB); PG8_STAGE(PG8_SA(1, 0), cA + kstep, voffA); PG8_STAGE(PG8_SB(1, 1), cB + hstep + kstep, voffB);
        PG8_WAIT_V(6); PG8_BAR;
    } else {
        PG8_STAGE(PG8_SB(0, 0), cB, voffB); PG8_STAGE(PG8_SA(0, 0), cA, voffA); PG8_STAGE(PG8_SB(0, 1), cB + hstep, voffB); PG8_STAGE(PG8_SA(0, 1), cA + hstep, voffA);
        if (wr == 1) PG8_BAR;
        PG8_WAIT_V(4); PG8_BAR;
        PG8_STAGE(PG8_SB(1, 0), cB + kstep, voffB); PG8_STAGE(PG8_SA(1, 0), cA + kstep, voffA); PG8_STAGE(PG8_SB(1, 1), cB + hstep + kstep, voffB);
        PG8_WAIT_V(6); PG8_BAR;
    }
    for (;;) {
        const bool has_next = S.next(ui + 1, nxt);
        const char* nA = has_next ? (const char*)g.A + (size_t)nxt.pm * tstep + (size_t)nxt.k0 * kstep : cA; const char* nB = has_next ? (const char*)g.Bt + (size_t)nxt.pn * tstep + (size_t)nxt.k0 * kstep : cB;
        const int nt = cur.nt;
        for (int t = 0; t < nt; t += 2) {
            const bool last = (t == nt - 2);
            const char* a1 = cA + (size_t)(t + 1) * kstep;
            const char* a2 = last ? nA : cA + (size_t)(t + 2) * kstep; const char* b2 = last ? nB : cB + (size_t)(t + 2) * kstep;
            const char* a3 = a2 + kstep; const char* b3 = b2 + kstep;
            if (last && has_next) S.a_ready(nxt);
            if constexpr (SP2) {
            PG8_LDB(B0, 0, 0); PG8_LDB(B1, 0, 1); PG8_SCHED; PG8_LDA(At, 0, 0); PG8_STAGE(PG8_SA(1, 1), a1 + hstep, voffA);
            PG8_WAIT_V(8); PG8_WAIT_L(0); PG8_BAR; PG8_MMA(0, 0, At, B0); PG8_MMA(0, 1, At, B1); PG8_BAR; PG8_SCHED;
            PG8_LDA(At, 0, 1); PG8_STAGE(PG8_SB(0, 0), b2, voffB); PG8_STAGE(PG8_SB(0, 1), b2 + hstep, voffB); PG8_STAGE(PG8_SA(0, 0), a2, voffA);
            PG8_WAIT_V(8); PG8_WAIT_L(0); PG8_BAR; PG8_MMA(1, 0, At, B0); PG8_MMA(1, 1, At, B1); PG8_BAR; PG8_SCHED;
            PG8_LDB(B0, 1, 0); PG8_LDB(B1, 1, 1); PG8_SCHED; PG8_LDA(At, 1, 0); PG8_STAGE(PG8_SA(0, 1), a2 + hstep, voffA);
            PG8_WAIT_V(8); PG8_WAIT_L(0); PG8_BAR; PG8_MMA(0, 0, At, B0); PG8_MMA(0, 1, At, B1); PG8_BAR; PG8_SCHED;
            PG8_LDA(At, 1, 1); PG8_STAGE(PG8_SB(1, 0), b3, voffB); PG8_STAGE(PG8_SB(1, 1), b3 + hstep, voffB); PG8_STAGE(PG8_SA(1, 0), a3, voffA);
            PG8_WAIT_V(8); PG8_WAIT_L(0); PG8_BAR; PG8_MMA(1, 0, At, B0); PG8_MMA(1, 1, At, B1); PG8_BAR; PG8_SCHED;
            } else {
            PG8_LDB(B0, 0, 0); PG8_SCHED; PG8_LDA(At, 0, 0); PG8_STAGE(PG8_SA(1, 1), a1 + hstep, voffA);
            PG8_WAIT_L(8); PG8_BAR; PG8_WAIT_L(0); PG8_MMA(0, 0, At, B0); PG8_BAR; PG8_SCHED;
            PG8_LDB(B1, 0, 1); PG8_STAGE(PG8_SB(0, 0), b2, voffB);
            PG8_BAR; PG8_WAIT_L(0); PG8_MMA(0, 1, At, B1); PG8_BAR;
            PG8_LDA(At, 0, 1); PG8_STAGE(PG8_SA(0, 0), a2, voffA);
            PG8_BAR; PG8_WAIT_L(0); PG8_MMA(1, 0, At, B0); PG8_BAR; PG8_SCHED;
            PG8_STAGE(PG8_SB(0, 1), b2 + hstep, voffB);
            PG8_WAIT_V(6); PG8_BAR; PG8_MMA(1, 1, At, B1); PG8_BAR;
            PG8_LDB(B0, 1, 0); PG8_SCHED; PG8_LDA(At, 1, 0); PG8_STAGE(PG8_SA(0, 1), a2 + hstep, voffA);
            PG8_WAIT_L(8); PG8_BAR; PG8_WAIT_L(0); PG8_MMA(0, 0, At, B0); PG8_BAR; PG8_SCHED;
            PG8_LDB(B1, 1, 1); PG8_STAGE(PG8_SB(1, 0), b3, voffB);
            PG8_BAR; PG8_WAIT_L(0); PG8_MMA(0, 1, At, B1); PG8_BAR;
            PG8_LDA(At, 1, 1); PG8_STAGE(PG8_SA(1, 0), a3, voffA);
            PG8_BAR; PG8_WAIT_L(0); PG8_MMA(1, 0, At, B0); PG8_BAR; PG8_SCHED;
            PG8_STAGE(PG8_SB(1, 1), b3 + hstep, voffB);
            PG8_WAIT_V(6); PG8_BAR; PG8_MMA(1, 1, At, B1); PG8_BAR;
            }
        }
        if constexpr (ALIGN_EPI) { if (wr == 0) PG8_BAR; }
        if constexpr (!Epi::AFTER_DRAIN) { E(acc, cur, wr, wc, fr, fq); S.done(cur); }
        if (!has_next) break;
#pragma unroll
        for (int a = 0; a < 2; ++a)
#pragma unroll
            for (int b = 0; b < 2; ++b)
#pragma unroll
                for (int m = 0; m < 4; ++m)
#pragma unroll
                    for (int n = 0; n < 2; ++n) acc[a][b][m][n] = (f32x4){0.f, 0.f, 0.f, 0.f};
        cur = nxt; cA = nA; cB = nB; ++ui;
        if constexpr (ALIGN_EPI) { if (wr == 1) PG8_BAR; }
    }
    PG8_WAIT_V(0);
    if constexpr (!ALIGN_EPI) { if (wr == 0) PG8_BAR; }
    PG8_BAR;
    if constexpr (Epi::AFTER_DRAIN) { E.fused(acc, cur, wr, wc, fr, fq, lds, wid, lane); S.done(cur); }
#undef PG8_SA
#undef PG8_SB
#undef PG8_STAGE
#undef PG8_LDA
#undef PG8_LDB
#undef PG8_MMA
#undef PG8_WAIT_V
#undef PG8_WAIT_L
#undef PG8_BAR
#undef PG8_SCHED
}
}
namespace pg8 {
struct EpiZ {
    static constexpr bool PERM = true, AFTER_DRAIN = false;
    bf16_t* O; int ldc; float* slab; const float* EB; const float* COS; const float* SIN;
    __device__ __forceinline__ void operator()(const f32x4 (&acc)[2][2][4][2], const Unit& u, int wr, int wc, int fr, int fq) const {
        const int row0 = u.pm * BM + wr * 64 + fr, col0 = u.pn * BM + wc * 32 + 8 * fq;
        if (u.kind == 1) { const int ks = u.k0 / u.nt;
#pragma unroll
            for (int m = 0; m < 4; ++m) { float* sp = slab + (size_t)(ks * 128 + wr * 64 + m * 16 + fr) * ldc + col0;
#pragma unroll
                for (int bj = 0; bj < 2; ++bj) { *(f32x4*)(sp + bj * HALF) = acc[0][bj][m][0]; *(f32x4*)(sp + bj * HALF + 4) = acc[0][bj][m][1]; } }
            return; }
        const int pn = u.pn;
        if (pn < 8) {
            const bool isq = pn < 4; const int ch0 = col0 - (isq ? 0 : 1024);
#pragma unroll
            for (int ai = 0; ai < 2; ++ai)
#pragma unroll
                for (int m = 0; m < 4; ++m) { const int r = row0 + ai * HALF + m * 16; bf16_t* rowp = O + (size_t)r * ldc + col0; const float* ebp = EB + (size_t)r * 1024 + ch0;
#pragma unroll
                    for (int bj = 0; bj < 2; ++bj) { const f32x4 b0 = *(const f32x4*)(ebp + bj * HALF), b1 = *(const f32x4*)(ebp + bj * HALF + 4); f32x4 v0 = acc[ai][bj][m][0], v1 = acc[ai][bj][m][1];
#pragma unroll
                        for (int e = 0; e < 4; ++e) { v0[e] *= isq ? 0.0625f * __expf(b0[e]) : __expf(-b0[e]); v1[e] *= isq ? 0.0625f * __expf(b1[e]) : __expf(-b1[e]); }
                        u32x4 w; w.x = cvt_pk_bf16(v0[0], v0[1]); w.y = cvt_pk_bf16(v0[2], v0[3]); w.z = cvt_pk_bf16(v1[0], v1[1]); w.w = cvt_pk_bf16(v1[2], v1[3]);
                        *(u32x4*)(rowp + bj * HALF) = w; } }
            return; }
        if (pn >= 24 && pn < 40) {
            const bool isq = pn < 32; const int h = isq ? pn - 24 : pn - 32; const int i0 = wc * 32 + 8 * fq;
            const float lg = __logf(1.0f - exp2f(-5.0f - (float)h));
#pragma unroll
            for (int ai = 0; ai < 2; ++ai)
#pragma unroll
                for (int m = 0; m < 4; ++m) { const int r = row0 + ai * HALF + m * 16; bf16_t* rowp = O + (size_t)r * ldc + col0; const int pos = r & 2047; const float t1 = (float)((r & 63) + 1);
                    const float sc = isq ? __expf(lg * t1) : 0.0625f * __expf(-lg * t1);
                    const float* cp = COS + pos * 128 + i0; const float* sp = SIN + pos * 128 + i0;
                    const f32x4 c0 = *(const f32x4*)cp, c1 = *(const f32x4*)(cp + 4), s0 = *(const f32x4*)sp, s1 = *(const f32x4*)(sp + 4);
                    const f32x4 a0 = acc[ai][0][m][0], a1 = acc[ai][0][m][1], b0 = acc[ai][1][m][0], b1 = acc[ai][1][m][1];
                    const f32x4 y00 = (a0 * c0 - b0 * s0) * sc, y01 = (a1 * c1 - b1 * s1) * sc, y10 = (a0 * s0 + b0 * c0) * sc, y11 = (a1 * s1 + b1 * c1) * sc;
                    u32x4 w; w.x = cvt_pk_bf16(y00[0], y00[1]); w.y = cvt_pk_bf16(y00[2], y00[3]); w.z = cvt_pk_bf16(y01[0], y01[1]); w.w = cvt_pk_bf16(y01[2], y01[3]);
                    *(u32x4*)rowp = w;
                    w.x = cvt_pk_bf16(y10[0], y10[1]); w.y = cvt_pk_bf16(y10[2], y10[3]); w.z = cvt_pk_bf16(y11[0], y11[1]); w.w = cvt_pk_bf16(y11[2], y11[3]);
                    *(u32x4*)(rowp + HALF) = w; }
            return; }
#pragma unroll
        for (int ai = 0; ai < 2; ++ai)
#pragma unroll
            for (int m = 0; m < 4; ++m) { bf16_t* rowp = O + (size_t)(row0 + ai * HALF + m * 16) * ldc + col0;
#pragma unroll
                for (int bj = 0; bj < 2; ++bj) { const f32x4 v0 = acc[ai][bj][m][0], v1 = acc[ai][bj][m][1];
                    u32x4 w; w.x = cvt_pk_bf16(v0[0], v0[1]); w.y = cvt_pk_bf16(v0[2], v0[3]); w.z = cvt_pk_bf16(v1[0], v1[1]); w.w = cvt_pk_bf16(v1[2], v1[3]);
                    *(u32x4*)(rowp + bj * HALF) = w; } }
    }
};
struct EpiResid {
    static constexpr bool PERM = false, AFTER_DRAIN = false;
    const float* xp; const float* xs; float* H; float* slab;
    __device__ __forceinline__ void operator()(const f32x4 (&acc)[2][2][4][2], const Unit& u, int wr, int wc, int fr, int fq) const {
        const int row0 = u.pm * BM + wr * 64 + fr, col0 = u.pn * BM + wc * 32 + 4 * fq;
        if (u.kind == 1) { const int ks = u.k0 / u.nt;
#pragma unroll
            for (int m = 0; m < 4; ++m) { float* sp = slab + (size_t)(ks * 128 + wr * 64 + m * 16 + fr) * 2048 + col0;
#pragma unroll
                for (int bj = 0; bj < 2; ++bj)
#pragma unroll
                    for (int n = 0; n < 2; ++n) *(f32x4*)(sp + bj * HALF + n * 16) = acc[0][bj][m][n]; }
            return; }
#pragma unroll
        for (int ai = 0; ai < 2; ++ai)
#pragma unroll
            for (int m = 0; m < 4; ++m) { const int r = row0 + ai * HALF + m * 16;
                const float* xr = r < 8192 ? xp + (size_t)r * 2048 : xs + (size_t)(r - 8192) * 2048; const bool real = r < 8320;
                float* hp = H + (size_t)r * 2048 + col0;
#pragma unroll
                for (int bj = 0; bj < 2; ++bj)
#pragma unroll
                    for (int n = 0; n < 2; ++n) { f32x4 xv = (f32x4){0.f, 0.f, 0.f, 0.f}; if (real) xv = *(const f32x4*)(xr + col0 + bj * HALF + n * 16);
                        *(f32x4*)(hp + bj * HALF + n * 16) = acc[ai][bj][m][n] + xv; } }
    }
};
struct EpiF32 {
    static constexpr bool PERM = false, AFTER_DRAIN = false;
    float* C;
    __device__ __forceinline__ void operator()(const f32x4 (&acc)[2][2][4][2], const Unit& u, int wr, int wc, int fr, int fq) const {
        const int row0 = u.pm * BM + wr * 64 + fr, col0 = u.pn * BM + wc * 32 + 4 * fq;
#pragma unroll
        for (int ai = 0; ai < 2; ++ai)
#pragma unroll
            for (int m = 0; m < 4; ++m) { float* cp = C + (size_t)(row0 + ai * HALF + m * 16) * 2048 + col0;
#pragma unroll
                for (int bj = 0; bj < 2; ++bj)
#pragma unroll
                    for (int n = 0; n < 2; ++n) *(f32x4*)(cp + bj * HALF + n * 16) = acc[ai][bj][m][n]; }
    }
};
struct EpiGate {
    static constexpr bool PERM = false, AFTER_DRAIN = false;
    const float* H; const float* PP; float* out; float* slab;
    __device__ __forceinline__ void operator()(const f32x4 (&acc)[2][2][4][2], const Unit& u, int wr, int wc, int fr, int fq) const {
        const int row0 = u.pm * BM + wr * 64 + fr, col0 = u.pn * BM + wc * 32 + 4 * fq;
        if (u.kind == 1) { const int ks = u.k0 / u.nt;
#pragma unroll
            for (int m = 0; m < 4; ++m) { float* sp = slab + (size_t)(ks * 128 + wr * 64 + m * 16 + fr) * 2048 + col0;
#pragma unroll
                for (int bj = 0; bj < 2; ++bj)
#pragma unroll
                    for (int n = 0; n < 2; ++n) *(f32x4*)(sp + bj * HALF + n * 16) = acc[0][bj][m][n]; }
            return; }
#pragma unroll
        for (int ai = 0; ai < 2; ++ai)
#pragma unroll
            for (int m = 0; m < 4; ++m) { const int r = row0 + ai * HALF + m * 16; if (r < 8320) { const size_t off = (size_t)r * 2048 + col0;
#pragma unroll
                for (int bj = 0; bj < 2; ++bj)
#pragma unroll
                    for (int n = 0; n < 2; ++n) { const f32x4 hv = *(const f32x4*)(H + off + bj * HALF + n * 16), pv = *(const f32x4*)(PP + off + bj * HALF + n * 16), a = acc[ai][bj][m][n]; f32x4 o;
#pragma unroll
                        for (int e = 0; e < 4; ++e) o[e] = hv[e] + pv[e] / (1.f + __expf(-a[e]));
                        *(f32x4*)(out + off + bj * HALF + n * 16) = o; } } }
    }
};
}
constexpr int NWAVES = 8;
#ifndef MK_N_LAUNCHES
#define MK_N_LAUNCHES 1
#endif
constexpr int N_LAUNCHES = MK_N_LAUNCHES;
constexpr int PER_PHASE = 9;
constexpr int PROBE_PHASE = -1;
constexpr int REP0 = 1, REP1 = 1, REP3A = 1, REP3B = 1, REP4 = 1, REP5 = 1, REP6 = 1, REP7 = 1;
constexpr int DM = 2048, MP = 8192, MS = 128, MR = 8320, MPAD = 8448, SEQ = 2048;
constexpr int NIN = 18448, NZ = 18432, PLE = 256;
constexpr int ZQA = 0, ZKA = 1024, ZVA = 2048, ZGA = 4096, ZQB = 6144, ZKB = 8192, ZVB = 10240, ZGB = 12288, ZMA = 14336, ZMB = 16384;
constexpr int SRC_RA = 6144;
constexpr float EPS = 1e-6f;
constexpr size_t MiB = 1u << 20;
constexpr size_t WS_CTL = 0, CTL_ZERO_BYTES = 64 * 1024;
constexpr size_t WS_WIN = 1 * MiB;
constexpr size_t WS_WOUT = 73 * MiB;
constexpr size_t WS_WGATE = 81 * MiB;
constexpr size_t WS_WPP = 89 * MiB;
constexpr size_t WS_U = 90 * MiB;
constexpr size_t WS_PB = 123 * MiB;
constexpr size_t WS_RA = 128 * MiB;
constexpr size_t WS_COS = 129 * MiB;
constexpr size_t WS_SIN = 130 * MiB + 65536;
constexpr size_t WS_DLAST = 132 * MiB;
constexpr size_t WS_Z = 133 * MiB;
constexpr size_t WS_OA = 430 * MiB;
constexpr size_t WS_OB = 496 * MiB;
constexpr size_t WS_MERGED = 562 * MiB;
constexpr size_t WS_H = 595 * MiB;
constexpr size_t WS_PP = 661 * MiB;
constexpr size_t WS_HN = 727 * MiB;
constexpr size_t WS_ZSLAB = 760 * MiB;
constexpr size_t WS_SLAB2 = 832 * MiB;
constexpr size_t WS_EB = 840 * MiB;
constexpr size_t WS_END = 872 * MiB;
constexpr int NSPLIT = 8;
static_assert(WS_Z + (size_t)MPAD * NZ * 2 <= WS_OA && WS_WIN + (size_t)NZ * DM * 2 <= WS_WOUT, "ws map");
constexpr size_t OUT_Y = 0, OUT_GLA_P = (size_t)MR * DM, OUT_RET_P = OUT_GLA_P + 2097152, OUT_GLA_S = OUT_RET_P + 2097152, OUT_RET_S = OUT_GLA_S + 67108864, OUT_END = OUT_RET_S + 67108864;
constexpr int CW_BAR = 4096;
constexpr int RING_OFF = 0, RING_BYTES = 131072;
constexpr int LDS_BYTES = 160 * 1024;
constexpr int MISC_OFF = LDS_BYTES - 256;
#define GAS __attribute__((address_space(1)))
#define LAS __attribute__((address_space(3)))
typedef unsigned short bf16;
typedef unsigned v4u __attribute__((ext_vector_type(4)));
typedef unsigned v2u __attribute__((ext_vector_type(2)));
typedef float f32x4 __attribute__((ext_vector_type(4)));
typedef short bf16x8 __attribute__((ext_vector_type(8)));
typedef GAS unsigned gu32;
#define LDS_WAIT() asm volatile("s_waitcnt lgkmcnt(0)" ::: "memory")
__device__ __forceinline__ unsigned f2bf(float f) { unsigned u = __builtin_bit_cast(unsigned, f); return (u + 0x7fffu + ((u >> 16) & 1u)) >> 16; }
__device__ __forceinline__ unsigned pk2(float lo, float hi) { return f2bf(lo) | (f2bf(hi) << 16); }
__device__ __forceinline__ float bf2f(unsigned b) { return __builtin_bit_cast(float, b << 16); }
__device__ __forceinline__ float bflo(unsigned w) { return __builtin_bit_cast(float, w << 16); }
__device__ __forceinline__ float bfhi(unsigned w) { return __builtin_bit_cast(float, w & 0xffff0000u); }
__device__ __forceinline__ float sigm(float x) { return 1.f / (1.f + __expf(-x)); }
__device__ __forceinline__ float log_sigmoid(float x) { return fminf(x, 0.f) - log1pf(expf(-fabsf(x))); }
__device__ __forceinline__ float wave_sum(float v) {
#pragma unroll
    for (int o = 1; o < 64; o <<= 1) v += __shfl_xor(v, o);
    return v;
}
#define XB_SPIN_CAP_OVERRIDE 1
#define XB_TMO      128
#define XB_XCNT(j)  (256  + 64 * (j))
#define XB_XSUB(j)  (1280 + 64 * (j))
#define XB_XGEN(j)  (2304 + 64 * (j))
#define XB_TOP      3328
#define XB_TOPGEN   3392
#define XCD_BAR_WORDS 3456
#define XB_SPIN_CAP (1u << 23)

__device__ __forceinline__ unsigned xb_ld(unsigned* p)              { return __hip_atomic_load(p, __ATOMIC_RELAXED, __HIP_MEMORY_SCOPE_AGENT); }
__device__ __forceinline__ unsigned xb_add(unsigned* p, unsigned v) { return __hip_atomic_fetch_add(p, v, __ATOMIC_RELAXED, __HIP_MEMORY_SCOPE_AGENT); }
__device__ __forceinline__ unsigned xb_xcc_id() { return (unsigned)__builtin_amdgcn_s_getreg((3 << 11) | 20) & 0xFu; }
#define XB_SPIN(cond, bar) do { unsigned _sp = 0; while (cond) { __builtin_amdgcn_s_sleep(1); \
    if ((++_sp & 255u) == 0u) { if (xb_ld(&(bar)[XB_TMO])) break; if (_sp > XB_SPIN_CAP) { atomicAdd(&(bar)[XB_TMO], 1u); break; } } } } while (0)

struct XcdBarrier {
    unsigned* bar; unsigned x;
    volatile LAS unsigned* st;
};

__device__ __forceinline__ XcdBarrier xcd_barrier_post(unsigned* bar, volatile LAS unsigned* st) {
    XcdBarrier b; b.bar = bar; b.x = xb_xcc_id(); b.st = st;
    if (threadIdx.x == 0) (void)xb_add(&bar[XB_XCNT(b.x)], 1u);
    return b;
}
__device__ __forceinline__ void xcd_barrier_complete(unsigned* bar, unsigned x, unsigned& nloc, unsigned& nx) {
    const unsigned G = gridDim.x * gridDim.y * gridDim.z;
    unsigned sum, cnt, mine, sp = 0u;
    for (;;) {
        sum = 0u; cnt = 0u; mine = 0u;
#pragma unroll
        for (unsigned j = 0; j < 16; ++j) { const unsigned c = xb_ld(&bar[XB_XCNT(j)]); sum += c; cnt += (c > 0u) ? 1u : 0u; mine = (j == x) ? c : mine; }
        if (sum == G) break;
        __builtin_amdgcn_s_sleep(1);
        if ((++sp & 255u) == 0u) { if (xb_ld(&bar[XB_TMO])) break; if (sp > XB_SPIN_CAP) { atomicAdd(&bar[XB_TMO], 1u); break; } }
    }
    nloc = mine > 0u ? mine : 1u; nx = cnt > 0u ? cnt : 1u;
}

__device__ __forceinline__ void xcd_barrier(const XcdBarrier& b) {
    asm volatile("s_waitcnt vmcnt(0)" ::: "memory");
    __syncthreads();
    if (threadIdx.x == 0) {
        unsigned* bar = b.bar;
        __builtin_amdgcn_s_waitcnt(0);
        unsigned nloc = b.st[0], nx = b.st[1];
        if (nloc == 0u) { xcd_barrier_complete(bar, b.x, nloc, nx); b.st[0] = nloc; b.st[1] = nx; }
        const unsigned old = xb_add(&bar[XB_XSUB(b.x)], 1u);
        const unsigned gen = old / nloc;
        if (old + 1u == (gen + 1u) * nloc) {
            __builtin_amdgcn_fence(__ATOMIC_RELEASE, "agent");
            asm volatile("s_waitcnt vmcnt(0)" ::: "memory");
            const unsigned og = xb_add(&bar[XB_TOP], 1u);
            const unsigned tg = og / nx;
            if (og + 1u == (tg + 1u) * nx) xb_add(&bar[XB_TOPGEN], 1u);
            else XB_SPIN(xb_ld(&bar[XB_TOPGEN]) == tg, bar);
            __builtin_amdgcn_fence(__ATOMIC_ACQUIRE, "agent");
            xb_add(&bar[XB_XGEN(b.x)], 1u);
            asm volatile("s_waitcnt vmcnt(0)" ::: "memory");
        } else {
            XB_SPIN(xb_ld(&bar[XB_XGEN(b.x)]) == gen, bar);
            __builtin_amdgcn_fence(__ATOMIC_ACQUIRE, "agent");
            asm volatile("s_waitcnt vmcnt(0)" ::: "memory");
        }
    }
    __syncthreads();
}
struct Args { const float* in[16]; float* out; unsigned char* ws; int ph_lo, ph_hi, li, pad; };
enum { I_XP = 0, I_XS, I_SGLA, I_SRET, I_PP, I_PS, I_NMIX, I_WIN, I_WUP, I_BGLA, I_GNORM, I_WOUT, I_NPLE, I_WGATE, I_WPP, I_NFIN };

__device__ __forceinline__ void p0_transpose_item(const float* W, int K, int Nsrc, int nblk, bf16* WT, LAS float* scr, int item, int lane, int gap_at) {
    const int kb = item / nblk, nb = item % nblk, k0 = 64 * kb, n0 = 32 * nb, ns = n0 + (n0 >= gap_at ? 16 : 0);
#pragma unroll 8
    for (int i = 0; i < 32; ++i) { const int kk = 2 * i + (lane >> 5); scr[kk * 33 + (lane & 31)] = W[(size_t)(k0 + kk) * Nsrc + ns + (lane & 31)]; }
    LDS_WAIT(); asm volatile("" ::: "memory");
    const int c = lane & 7;
#pragma unroll
    for (int j = 0; j < 4; ++j) { const int n = (lane >> 3) + 8 * j; const LAS float* s = scr + (8 * c) * 33 + n;
        v4u o; o.x = pk2(s[0 * 33], s[1 * 33]); o.y = pk2(s[2 * 33], s[3 * 33]); o.z = pk2(s[4 * 33], s[5 * 33]); o.w = pk2(s[6 * 33], s[7 * 33]);
        *(GAS v4u*)(WT + (size_t)(n0 + n) * K + k0 + 8 * c) = o; }
    LDS_WAIT(); asm volatile("" ::: "memory");
}
__device__ __forceinline__ const float* xrow_ptr(const Args& a, int r) { return r < MP ? a.in[I_XP] + (size_t)r * DM : a.in[I_XS] + (size_t)(r - MP) * DM; }

__device__ __forceinline__ void p0_rows(const Args& a, int gw, int NGW, int lane) {
    unsigned char* ws = a.ws;
    {
        const float* g = a.in[I_NMIX]; const float* wr = a.in[I_WIN] + SRC_RA; bf16* U = (bf16*)(ws + WS_U); float* RA = (float*)(ws + WS_RA);
        for (int rp = gw; rp < MR / 2; rp += NGW) {
            const int r0 = 2 * rp;
            const f32x4* x0 = (const f32x4*)xrow_ptr(a, r0) + lane; const f32x4* x1 = (const f32x4*)xrow_ptr(a, r0 + 1) + lane;
            f32x4 v0[8], v1[8]; float s0 = 0.f, s1 = 0.f;
#pragma unroll
            for (int j = 0; j < 8; ++j) { v0[j] = x0[64 * j]; v1[j] = x1[64 * j];
                s0 += (v0[j].x * v0[j].x + v0[j].y * v0[j].y) + (v0[j].z * v0[j].z + v0[j].w * v0[j].w);
                s1 += (v1[j].x * v1[j].x + v1[j].y * v1[j].y) + (v1[j].z * v1[j].z + v1[j].w * v1[j].w); }
            const float rs0 = rsqrtf(wave_sum(s0) * (1.f / DM) + EPS), rs1 = rsqrtf(wave_sum(s1) * (1.f / DM) + EPS);
            float acc0[16], acc1[16];
#pragma unroll
            for (int q = 0; q < 16; ++q) { acc0[q] = 0.f; acc1[q] = 0.f; }
            unsigned long long* o0 = (unsigned long long*)(U + (size_t)r0 * DM) + lane; unsigned long long* o1 = (unsigned long long*)(U + (size_t)(r0 + 1) * DM) + lane;
#pragma unroll
            for (int j = 0; j < 8; ++j) {
                const f32x4 gv = *((const f32x4*)g + lane + 64 * j);
                f32x4 u0 = v0[j] * rs0 * gv, u1 = v1[j] * rs1 * gv;
                o0[64 * j] = (unsigned long long)pk2(u0.x, u0.y) | ((unsigned long long)pk2(u0.z, u0.w) << 32);
                o1[64 * j] = (unsigned long long)pk2(u1.x, u1.y) | ((unsigned long long)pk2(u1.z, u1.w) << 32);
#pragma unroll
                for (int e = 0; e < 4; ++e) { const int k = 256 * j + 4 * lane + e; const f32x4* wp = (const f32x4*)(wr + (size_t)k * NIN);
#pragma unroll
                    for (int q4 = 0; q4 < 4; ++q4) { const f32x4 w = wp[q4];
#pragma unroll
                        for (int t = 0; t < 4; ++t) { acc0[q4 * 4 + t] += u0[e] * w[t]; acc1[q4 * 4 + t] += u1[e] * w[t]; } } }
            }
#pragma unroll
            for (int q = 0; q < 16; ++q) { acc0[q] = wave_sum(acc0[q]); acc1[q] = wave_sum(acc1[q]); }
            if (lane < 16) { float s = 0.f, t = 0.f;
#pragma unroll
                for (int q = 0; q < 16; ++q) { s = (lane == q) ? acc0[q] : s; t = (lane == q) ? acc1[q] : t; }
                RA[(size_t)r0 * 16 + lane] = s; RA[(size_t)(r0 + 1) * 16 + lane] = t; }
        }
    }
    {
        bf16* PB = (bf16*)(ws + WS_PB); const int tid = gw * 64 + lane, NT = NGW * 64;
        for (int i = tid; i < MR * (PLE / 4); i += NT) { const int r = i / (PLE / 4), c4 = i % (PLE / 4);
            const float* src = r < MP ? a.in[I_PP] + (size_t)r * PLE : a.in[I_PS] + (size_t)(r - MP) * PLE;
            const f32x4 v = *((const f32x4*)src + c4);
            *((unsigned long long*)(PB + (size_t)r * PLE) + c4) = (unsigned long long)pk2(v.x, v.y) | ((unsigned long long)pk2(v.z, v.w) << 32); }
        float* CT = (float*)(ws + WS_COS); float* ST = (float*)(ws + WS_SIN);
        for (int i = tid; i < 2049 * 128; i += NT) { const int pr = i >> 7, ii = i & 127; const float pos = pr == 2048 ? 16384.f : (float)pr;
            const float e = (float)ii / 127.0f; const float inv = 1.0f / powf(10000.0f, e); const float ang = pos * inv;
            const double rev = (double)ang * 0.15915494309189533577; const float fr = (float)(rev - __builtin_rint(rev));
            CT[i] = __builtin_amdgcn_cosf(fr); ST[i] = __builtin_amdgcn_sinf(fr); }
    }
}
__device__ __forceinline__ void p1_prep(const Args& a, LAS unsigned char* lds, int vcu, int G, int gw, int NGW, int tid, int wave, int lane) {
    unsigned char* ws = a.ws;
    {
        const float* RA = (const float*)(ws + WS_RA); float* EB = (float*)(ws + WS_EB); float* DL = (float*)(ws + WS_DLAST); const float* wup = a.in[I_WUP]; const float* bg = a.in[I_BGLA];
        for (int it = vcu; it < 256; it += G) { const int g = it >> 1, c = (it & 1) * 512 + tid;
            float w[16];
#pragma unroll
            for (int j = 0; j < 16; ++j) w[j] = wup[j * 1024 + c];
            const float bias = bg[c]; float bc = 0.f;
#pragma unroll 4
            for (int t = 0; t < 64; ++t) { const int row = g * 64 + t; const float* ra = RA + (size_t)row * 16; float x = bias;
#pragma unroll
                for (int j = 0; j < 16; ++j) x += ra[j] * w[j];
                bc += (fminf(x, 0.f) - __logf(1.0f + __expf(-fabsf(x)))) * (1.f / 16.f);
                EB[(size_t)row * 1024 + c] = bc; }
            DL[(size_t)g * 1024 + c] = __expf(bc); }
    }
    LAS float* scr = (LAS float*)(lds + RING_OFF + wave * 16384);
    constexpr int I_IN = (DM / 64) * (NZ / 32), I_O = (DM / 64) * (DM / 32), I_G = I_O, I_P = (PLE / 64) * (DM / 32);
    constexpr int NITEMS = I_IN + I_O + I_G + I_P;
    for (int it = gw; it < NITEMS; it += NGW) {
        int r = it;
        if (r < I_IN) { p0_transpose_item(a.in[I_WIN], DM, NIN, NZ / 32, (bf16*)(ws + WS_WIN), scr, r, lane, SRC_RA); continue; } r -= I_IN;
        if (r < I_O) { p0_transpose_item(a.in[I_WOUT], DM, DM, DM / 32, (bf16*)(ws + WS_WOUT), scr, r, lane, 1 << 30); continue; } r -= I_O;
        if (r < I_G) { p0_transpose_item(a.in[I_WGATE], DM, DM, DM / 32, (bf16*)(ws + WS_WGATE), scr, r, lane, 1 << 30); continue; } r -= I_G;
        p0_transpose_item(a.in[I_WPP], PLE, DM, DM / 32, (bf16*)(ws + WS_WPP), scr, r, lane, 1 << 30);
    }
}
constexpr int QS_STR = 528, KT_STR = 144;
constexpr int R_QS = 0, R_KS = 33792, R_KT = 67584, R_VT = 104448, R_AS = 113664, R_ST = 122880, R_END = 156672;
static_assert(R_END <= MISC_OFF, "recurrence LDS map");
__device__ __forceinline__ bf16x8 ldfrag(const LAS unsigned char* p) { return *(const LAS bf16x8*)p; }
__device__ __forceinline__ void p3_recurrence(const Args& a, LAS unsigned char* lds, int vcu, int G, int tid, int wave, int lane) {
    unsigned char* ws = a.ws; const bf16* Z = (const bf16*)(ws + WS_Z); const float* DL = (const float*)(ws + WS_DLAST);
    const int fr = lane & 15, fq = lane >> 4;
    for (int item = vcu; item < 256; item += G) {
        const bool gla = item < 128; const int it = gla ? item : item - 128;
        const int b = it >> 5, h = gla ? (it >> 3) & 3 : (it >> 2) & 7, ds = gla ? it & 7 : it & 3;
        const int dv = gla ? 512 : 256, nh = gla ? 4 : 8;
        const int cq = (gla ? ZQA : ZQB) + h * 256, ck = (gla ? ZKA : ZKB) + h * 256, cv = (gla ? ZVA : ZVB) + h * dv + ds * 64;
        float* O = (float*)(ws + (gla ? WS_OA : WS_OB)); const int ocol = h * dv + ds * 64;
        const float lgam = logf(1.0f - exp2f(-5.0f - (float)h)); const float dret = expf(64.f * lgam);
        f32x4 sacc[2][4];
#pragma unroll
        for (int ci = 0; ci < 2; ++ci)
#pragma unroll
            for (int di = 0; di < 4; ++di) sacc[ci][di] = (f32x4){0.f, 0.f, 0.f, 0.f};
        for (int i = tid; i < 33792 / 16; i += 512) *(LAS v4u*)(lds + R_ST + i * 16) = (v4u){0u, 0u, 0u, 0u};
        for (int n = 0; n < 32; ++n) {
            const int r0 = b * SEQ + n * 64;
#pragma unroll
            for (int i = 0; i < 4; ++i) { const int p = tid + 512 * i, row = p >> 5, pc = p & 31;
                const v4u vq = *(const v4u*)(Z + (size_t)(r0 + row) * NZ + cq + pc * 8), vk = *(const v4u*)(Z + (size_t)(r0 + row) * NZ + ck + pc * 8);
                *(LAS v4u*)(lds + R_QS + row * QS_STR + pc * 16) = vq; *(LAS v4u*)(lds + R_KS + row * QS_STR + pc * 16) = vk; }
#pragma unroll
            for (int i = 0; i < 4; ++i) { const int p = tid + 512 * i, s = p & 63, pc = p >> 6;
                const v4u vk = *(const v4u*)(Z + (size_t)(r0 + s) * NZ + ck + pc * 8);
                LAS unsigned short* kt = (LAS unsigned short*)(lds + R_KT + (pc * 8) * KT_STR + s * 2);
                kt[0 * (KT_STR / 2)] = (unsigned short)vk.x; kt[1 * (KT_STR / 2)] = (unsigned short)(vk.x >> 16); kt[2 * (KT_STR / 2)] = (unsigned short)vk.y; kt[3 * (KT_STR / 2)] = (unsigned short)(vk.y >> 16);
                kt[4 * (KT_STR / 2)] = (unsigned short)vk.z; kt[5 * (KT_STR / 2)] = (unsigned short)(vk.z >> 16); kt[6 * (KT_STR / 2)] = (unsigned short)vk.w; kt[7 * (KT_STR / 2)] = (unsigned short)(vk.w >> 16); }
            { const int s = tid & 63, pc = tid >> 6;
                const v4u vv = *(const v4u*)(Z + (size_t)(r0 + s) * NZ + cv + pc * 8);
                LAS unsigned short* vt = (LAS unsigned short*)(lds + R_VT + (pc * 8) * KT_STR + s * 2);
                vt[0 * (KT_STR / 2)] = (unsigned short)vv.x; vt[1 * (KT_STR / 2)] = (unsigned short)(vv.x >> 16); vt[2 * (KT_STR / 2)] = (unsigned short)vv.y; vt[3 * (KT_STR / 2)] = (unsigned short)(vv.y >> 16);
                vt[4 * (KT_STR / 2)] = (unsigned short)vv.z; vt[5 * (KT_STR / 2)] = (unsigned short)(vv.z >> 16); vt[6 * (KT_STR / 2)] = (unsigned short)vv.w; vt[7 * (KT_STR / 2)] = (unsigned short)(vv.w >> 16); }
            __syncthreads();
            { const int ti = wave >> 1;
#pragma unroll
                for (int sj = 0; sj < 2; ++sj) { const int si = 2 * (wave & 1) + sj; f32x4 acc = (f32x4){0.f, 0.f, 0.f, 0.f};
#pragma unroll
                    for (int kk = 0; kk < 8; ++kk) { const bf16x8 af = ldfrag(lds + R_QS + (ti * 16 + fr) * QS_STR + (kk * 32 + fq * 8) * 2), bfm = ldfrag(lds + R_KS + (si * 16 + fr) * QS_STR + (kk * 32 + fq * 8) * 2);
                        acc = __builtin_amdgcn_mfma_f32_16x16x32_bf16(af, bfm, acc, 0, 0, 0); }
                    const int s = si * 16 + fr;
#pragma unroll
                    for (int e = 0; e < 4; ++e) { const int t = ti * 16 + fq * 4 + e; const float v = (s <= t) ? acc[e] : 0.f;
                        *(LAS unsigned short*)(lds + R_AS + t * KT_STR + s * 2) = (unsigned short)f2bf(v); } } }
            __syncthreads();
            { const int ti = wave >> 1;
#pragma unroll
                for (int dj = 0; dj < 2; ++dj) { const int di = 2 * (wave & 1) + dj; f32x4 acc = (f32x4){0.f, 0.f, 0.f, 0.f};
#pragma unroll
                    for (int kk = 0; kk < 8; ++kk) { const bf16x8 af = ldfrag(lds + R_QS + (ti * 16 + fr) * QS_STR + (kk * 32 + fq * 8) * 2), bfm = ldfrag(lds + R_ST + (di * 16 + fr) * QS_STR + (kk * 32 + fq * 8) * 2);
                        acc = __builtin_amdgcn_mfma_f32_16x16x32_bf16(af, bfm, acc, 0, 0, 0); }
#pragma unroll
                    for (int kk = 0; kk < 2; ++kk) { const bf16x8 af = ldfrag(lds + R_AS + (ti * 16 + fr) * KT_STR + (kk * 32 + fq * 8) * 2), bfm = ldfrag(lds + R_VT + (di * 16 + fr) * KT_STR + (kk * 32 + fq * 8) * 2);
                        acc = __builtin_amdgcn_mfma_f32_16x16x32_bf16(af, bfm, acc, 0, 0, 0); }
#pragma unroll
                    for (int e = 0; e < 4; ++e) O[(size_t)(r0 + ti * 16 + fq * 4 + e) * DM + ocol + di * 16 + fr] = acc[e]; } }
#pragma unroll
            for (int ci = 0; ci < 2; ++ci) { const int ct = 2 * wave + ci;
#pragma unroll
                for (int kk = 0; kk < 2; ++kk) { const bf16x8 af = ldfrag(lds + R_KT + (ct * 16 + fr) * KT_STR + (kk * 32 + fq * 8) * 2);
#pragma unroll
                    for (int di = 0; di < 4; ++di) { const bf16x8 bfm = ldfrag(lds + R_VT + (di * 16 + fr) * KT_STR + (kk * 32 + fq * 8) * 2);
                        sacc[ci][di] = __builtin_amdgcn_mfma_f32_16x16x32_bf16(af, bfm, sacc[ci][di], 0, 0, 0); } } }
            __syncthreads();
#pragma unroll
            for (int ci = 0; ci < 2; ++ci) { const int c0 = (2 * wave + ci) * 16 + fq * 4; f32x4 dl;
                if (gla) dl = *(const f32x4*)(DL + (size_t)(b * 32 + n) * 1024 + h * 256 + c0); else dl = (f32x4){dret, dret, dret, dret};
#pragma unroll
                for (int di = 0; di < 4; ++di) { sacc[ci][di] = sacc[ci][di] * dl; const f32x4 v = sacc[ci][di];
                    v2u w; w.x = pk2(v[0], v[1]); w.y = pk2(v[2], v[3]);
                    *(LAS v2u*)(lds + R_ST + (di * 16 + fr) * QS_STR + c0 * 2) = w; } }
            __syncthreads();
        }
        float* SO = a.out + (gla ? OUT_GLA_P : OUT_RET_P) + (size_t)(b * nh + h) * 256 * dv + ds * 64;
#pragma unroll
        for (int ci = 0; ci < 2; ++ci)
#pragma unroll
            for (int di = 0; di < 4; ++di)
#pragma unroll
                for (int e = 0; e < 4; ++e) SO[(size_t)((2 * wave + ci) * 16 + fq * 4 + e) * dv + di * 16 + fr] = sacc[ci][di][e];
    }
}

__device__ __forceinline__ float slab_sum(const float* SL, int ld, int b, int col) { float s = 0.f;
#pragma unroll
    for (int ks = 0; ks < NSPLIT; ++ks) s += SL[(size_t)(ks * 128 + b) * ld + col];
    return s; }
__device__ __forceinline__ f32x4 slab_sum4(const float* SL, int ld, int b, int col) { f32x4 s = (f32x4){0.f, 0.f, 0.f, 0.f};
#pragma unroll
    for (int ks = 0; ks < NSPLIT; ++ks) s += *(const f32x4*)(SL + (size_t)(ks * 128 + b) * ld + col);
    return s; }
__device__ __forceinline__ void p3_decode(const Args& a, LAS unsigned char* lds, int vcu, int G, int tid) {
    unsigned char* ws = a.ws; const float* ZS = (const float*)(ws + WS_ZSLAB); const float* RA = (const float*)(ws + WS_RA); const float* CT = (const float*)(ws + WS_COS) + 2048 * 128; const float* ST = (const float*)(ws + WS_SIN) + 2048 * 128;
    const float* sgla = a.in[I_SGLA]; const float* sret = a.in[I_SRET];
    asm volatile("" : "+s"(sgla), "+s"(sret));
    LAS float* sa = (LAS float*)lds; LAS float* sq = sa + 256; LAS float* sk = sq + 256; LAS float* red = sk + 256;
    for (int item = vcu; item < 1536; item += G) {
        const bool gla = item < 512; const int it = gla ? item : item - 512;
        const int b = gla ? it >> 2 : it >> 3, h = gla ? it & 3 : it & 7, row = MP + b;
        __syncthreads();
        if (gla) { const int c = h * 256 + (tid & 255);
            if (tid < 256) { float x = a.in[I_BGLA][c];
#pragma unroll
                for (int j = 0; j < 16; ++j) x += RA[(size_t)row * 16 + j] * a.in[I_WUP][j * 1024 + c];
                sa[tid] = expf(log_sigmoid(x) * (1.f / 16.f)); sq[tid] = slab_sum(ZS, NZ, b, ZQA + c) * 0.0625f; }
            else sk[tid - 256] = slab_sum(ZS, NZ, b, ZKA + c); }
        else { const int wh = tid >> 7, i = tid & 127;
            red[tid] = slab_sum(ZS, NZ, b, (wh < 2 ? ZQB : ZKB) + h * 256 + (wh & 1) * 128 + i);
            __syncthreads();
            if (tid < 128) { const float cs = CT[i], sn = ST[i]; const float qa = red[i], qb = red[128 + i], ka = red[256 + i], kb = red[384 + i];
                sq[i] = qa * cs - qb * sn; sq[i + 128] = qa * sn + qb * cs; sk[i] = (ka * cs - kb * sn) * 0.0625f; sk[i + 128] = (ka * sn + kb * cs) * 0.0625f; } }
        __syncthreads();
        const int dv = gla ? 512 : 256, ngrp = gla ? 4 : 8, rows = gla ? 64 : 32, dg = gla ? (tid & 127) : (tid & 63), cg = gla ? (tid >> 7) : (tid >> 6);
        const float gam = 1.0f - exp2f(-5.0f - (float)h);
        const f32x4 v4 = slab_sum4(ZS, NZ, b, (gla ? ZVA + h * 512 : ZVB + h * 256) + 4 * dg);
        const size_t sbase = (size_t)(b * (gla ? 4 : 8) + h) * 256 * dv + 4 * dg;
        const float* Sin = (gla ? sgla : sret) + sbase; float* Sout = a.out + (gla ? OUT_GLA_S : OUT_RET_S) + sbase;
        f32x4 oacc = (f32x4){0.f, 0.f, 0.f, 0.f};
        for (int c0 = cg * rows; c0 < (cg + 1) * rows; c0 += 8) {
            f32x4 sv[8];
#pragma unroll
            for (int u = 0; u < 8; ++u) sv[u] = *(const f32x4*)(Sin + (size_t)(c0 + u) * dv);
#pragma unroll
            for (int u = 0; u < 8; ++u) { const int c = c0 + u; const float ac = gla ? sa[c] : gam; const f32x4 sn = sv[u] * ac + v4 * sk[c];
                *(f32x4*)(Sout + (size_t)c * dv) = sn; oacc += sn * sq[c]; }
        }
        __syncthreads();
        *(LAS f32x4*)(red + cg * 512 + 4 * dg) = oacc;
        __syncthreads();
        if (tid < dv / 4) { f32x4 s = (f32x4){0.f, 0.f, 0.f, 0.f};
            for (int g = 0; g < ngrp; ++g) s += *(LAS f32x4*)(red + g * 512 + 4 * tid);
            *(f32x4*)((float*)(ws + (gla ? WS_OA : WS_OB)) + (size_t)row * DM + h * dv + 4 * tid) = s; }
    }
    __syncthreads();
}

__device__ __forceinline__ void p4_merge(const Args& a, LAS unsigned char* lds, int vcu, int G, int gw, int NGW, int wave, int lane) {
    unsigned char* ws = a.ws; const bf16* Z = (const bf16*)(ws + WS_Z); const float* ZS = (const float*)(ws + WS_ZSLAB); const float* OA = (const float*)(ws + WS_OA); const float* OB = (const float*)(ws + WS_OB); bf16* MG = (bf16*)(ws + WS_MERGED);
    const float* gn = a.in[I_GNORM];
    for (int b = vcu; b < MS; b += G) { const int r = MP + b, col = 256 * wave + 4 * lane; LAS float* red = (LAS float*)lds;
        const f32x4 oa = *(const f32x4*)(OA + (size_t)r * DM + col), ob = *(const f32x4*)(OB + (size_t)r * DM + col);
        const f32x4 gav = slab_sum4(ZS, NZ, b, ZGA + col), gbv = slab_sum4(ZS, NZ, b, ZGB + col), mav = slab_sum4(ZS, NZ, b, ZMA + col), mbv = slab_sum4(ZS, NZ, b, ZMB + col);
        const float sa2 = wave_sum((oa.x * oa.x + oa.y * oa.y) + (oa.z * oa.z + oa.w * oa.w)), sb2 = wave_sum((ob.x * ob.x + ob.y * ob.y) + (ob.z * ob.z + ob.w * ob.w));
        __syncthreads(); if (lane == 0) red[wave] = sa2; __syncthreads();
        const float ra = rsqrtf((red[wave & ~1] + red[wave | 1]) * (1.f / 512.f) + EPS), rb = rsqrtf(sb2 * (1.f / 256.f) + EPS);
        const f32x4 gnv = *(const f32x4*)(gn + (col & 511)); float o[4];
#pragma unroll
        for (int e = 0; e < 4; ++e) { const float na = oa[e] * ra * gnv[e], nb = ob[e] * rb;
            o[e] = sigm(mav[e]) * (na * gav[e] * sigm(gav[e])) + sigm(mbv[e]) * (nb * gbv[e] * sigm(gbv[e])); }
        v2u w; w.x = pk2(o[0], o[1]); w.y = pk2(o[2], o[3]);
        *(v2u*)(MG + (size_t)r * DM + col) = w; }
    for (int r = gw; r < MP; r += NGW) {
        f32x4 oa[8], ob[8]; float sa2[8], sb2[8];
#pragma unroll
        for (int j = 0; j < 8; ++j) { oa[j] = *(const f32x4*)(OA + (size_t)r * DM + 256 * j + 4 * lane); ob[j] = *(const f32x4*)(OB + (size_t)r * DM + 256 * j + 4 * lane);
            sa2[j] = (oa[j].x * oa[j].x + oa[j].y * oa[j].y) + (oa[j].z * oa[j].z + oa[j].w * oa[j].w); sb2[j] = (ob[j].x * ob[j].x + ob[j].y * ob[j].y) + (ob[j].z * ob[j].z + ob[j].w * ob[j].w); }
        float ra[4], rb[8];
#pragma unroll
        for (int hh = 0; hh < 4; ++hh) ra[hh] = rsqrtf(wave_sum(sa2[2 * hh] + sa2[2 * hh + 1]) * (1.f / 512.f) + EPS);
#pragma unroll
        for (int hb = 0; hb < 8; ++hb) rb[hb] = rsqrtf(wave_sum(sb2[hb]) * (1.f / 256.f) + EPS);
        const bf16* zr = Z + (size_t)r * NZ;
#pragma unroll
        for (int j = 0; j < 8; ++j) { const int col = 256 * j + 4 * lane;
            const v2u ga = *(const v2u*)(zr + ZGA + col), gb = *(const v2u*)(zr + ZGB + col), ma = *(const v2u*)(zr + ZMA + col), mb = *(const v2u*)(zr + ZMB + col);
            const f32x4 gnv = *(const f32x4*)(gn + (col & 511));
            const float gav[4] = {bflo(ga.x), bfhi(ga.x), bflo(ga.y), bfhi(ga.y)}, gbv[4] = {bflo(gb.x), bfhi(gb.x), bflo(gb.y), bfhi(gb.y)};
            const float mav[4] = {bflo(ma.x), bfhi(ma.x), bflo(ma.y), bfhi(ma.y)}, mbv[4] = {bflo(mb.x), bfhi(mb.x), bflo(mb.y), bfhi(mb.y)};
            float o[4];
#pragma unroll
            for (int e = 0; e < 4; ++e) { const float na = oa[j][e] * ra[j >> 1] * gnv[e], nb = ob[j][e] * rb[j];
                o[e] = sigm(mav[e]) * (na * gav[e] * sigm(gav[e])) + sigm(mbv[e]) * (nb * gbv[e] * sigm(gbv[e])); }
            v2u w; w.x = pk2(o[0], o[1]); w.y = pk2(o[2], o[3]);
            *(v2u*)(MG + (size_t)r * DM + col) = w; }
    }
}
__device__ __forceinline__ float block_sum8(LAS float* red, float v, int wave, int lane) { v = wave_sum(v); __syncthreads(); if (lane == 0) red[wave] = v; __syncthreads();
    float s = 0.f;
#pragma unroll
    for (int w = 0; w < 8; ++w) s += red[w];
    return s; }
__device__ __forceinline__ void p6_norm_bf16(const Args& a, LAS unsigned char* lds, int vcu, int G, int gw, int NGW, int wave, int lane) {
    unsigned char* ws = a.ws; float* H = (float*)(ws + WS_H); const float* SL = (const float*)(ws + WS_SLAB2); bf16* HN = (bf16*)(ws + WS_HN); const float* g = a.in[I_NPLE];
    for (int b = vcu; b < MS; b += G) { const int r = MP + b, col = 256 * wave + 4 * lane;
        const f32x4 v = *(const f32x4*)(a.in[I_XS] + (size_t)b * DM + col) + slab_sum4(SL, DM, b, col);
        *(f32x4*)(H + (size_t)r * DM + col) = v;
        const float rs = rsqrtf(block_sum8((LAS float*)lds, (v.x * v.x + v.y * v.y) + (v.z * v.z + v.w * v.w), wave, lane) * (1.f / DM) + EPS);
        const f32x4 u = v * rs * *(const f32x4*)(g + col);
        *(unsigned long long*)(HN + (size_t)r * DM + col) = (unsigned long long)pk2(u.x, u.y) | ((unsigned long long)pk2(u.z, u.w) << 32); }
    for (int r = gw; r < MP; r += NGW) { const f32x4* x = (const f32x4*)(H + (size_t)r * DM) + lane; f32x4 v[8]; float s = 0.f;
#pragma unroll
        for (int j = 0; j < 8; ++j) { v[j] = x[64 * j]; s += (v[j].x * v[j].x + v[j].y * v[j].y) + (v[j].z * v[j].z + v[j].w * v[j].w); }
        const float rs = rsqrtf(wave_sum(s) * (1.f / DM) + EPS);
        unsigned long long* o = (unsigned long long*)(HN + (size_t)r * DM) + lane;
#pragma unroll
        for (int j = 0; j < 8; ++j) { const f32x4 gv = *((const f32x4*)g + lane + 64 * j); const f32x4 u = v[j] * rs * gv;
            o[64 * j] = (unsigned long long)pk2(u.x, u.y) | ((unsigned long long)pk2(u.z, u.w) << 32); } }
}
__device__ __forceinline__ void p8_norm_final(const Args& a, LAS unsigned char* lds, int vcu, int G, int gw, int NGW, int wave, int lane) {
    unsigned char* ws = a.ws; const float* H = (const float*)(ws + WS_H); const float* PPb = (const float*)(ws + WS_PP); const float* SL = (const float*)(ws + WS_SLAB2); const float* g = a.in[I_NFIN]; float* Y = a.out + OUT_Y;
    for (int b = vcu; b < MS; b += G) { const int r = MP + b, col = 256 * wave + 4 * lane;
        const f32x4 lg = slab_sum4(SL, DM, b, col), hv = *(const f32x4*)(H + (size_t)r * DM + col), pv = *(const f32x4*)(PPb + (size_t)r * DM + col); f32x4 v;
#pragma unroll
        for (int e = 0; e < 4; ++e) v[e] = hv[e] + pv[e] / (1.f + __expf(-lg[e]));
        const float rs = rsqrtf(block_sum8((LAS float*)lds, (v.x * v.x + v.y * v.y) + (v.z * v.z + v.w * v.w), wave, lane) * (1.f / DM) + EPS);
        *(f32x4*)(Y + (size_t)r * DM + col) = v * rs * *(const f32x4*)(g + col); }
    for (int r = gw; r < MP; r += NGW) { f32x4* x = (f32x4*)(Y + (size_t)r * DM) + lane; f32x4 v[8]; float s = 0.f;
#pragma unroll
        for (int j = 0; j < 8; ++j) { v[j] = x[64 * j]; s += (v[j].x * v[j].x + v[j].y * v[j].y) + (v[j].z * v[j].z + v[j].w * v[j].w); }
        const float rs = rsqrtf(wave_sum(s) * (1.f / DM) + EPS);
#pragma unroll
        for (int j = 0; j < 8; ++j) { const f32x4 gv = *((const f32x4*)g + lane + 64 * j); x[64 * j] = v[j] * rs * gv; } }
}
__global__ void __launch_bounds__(NWAVES * 64, 2) fwd_kernel(Args args) {
    extern __shared__ __attribute__((aligned(16))) unsigned char lds_raw[];
    LAS unsigned char* lds = (LAS unsigned char*)lds_raw;
    const int tid = threadIdx.x, lane = tid & 63, wave = __builtin_amdgcn_readfirstlane(tid >> 6);
    const int G = gridDim.x, bx = blockIdx.x;
    const int vcu = (G % 8 == 0) ? (bx % 8) * (G / 8) + bx / 8 : bx;
    const int gw = vcu * NWAVES + wave, NGW = G * NWAVES;
    volatile LAS unsigned* MISC = (volatile LAS unsigned*)(lds + MISC_OFF);
    if (tid < 64) MISC[tid] = 0u;
    __syncthreads();
    unsigned char* ws = args.ws;
    XcdBarrier bar; bar.bar = (unsigned*)(ws + WS_CTL) + CW_BAR; bar.x = 0; bar.st = nullptr;
    if (N_LAUNCHES == 1) bar = xcd_barrier_post((unsigned*)(ws + WS_CTL) + CW_BAR, MISC + 8);
    const int lo = args.ph_lo, hi = args.ph_hi;
#define IN(k) (lo <= (k) && (k) < hi)
#define SEAM(k) do { if (N_LAUNCHES == 1 && IN(k) && IN((k) + 1)) xcd_barrier(bar); } while (0)
    if (IN(0)) p0_rows(args, gw, NGW, lane);
    SEAM(0);
    if (IN(1)) p1_prep(args, lds, vcu, G, gw, NGW, tid, wave, lane);
    SEAM(1);
    if (IN(2)) {
        pg8::Gemm g{(const pg8::bf16_t*)(ws + WS_U), (const pg8::bf16_t*)(ws + WS_WIN), MPAD, NZ, DM}; pg8::SplitOrder S; S.init(MP / 256, NZ / 256, DM / 64, NSPLIT, 1, G, bx);
        pg8::EpiZ E{(pg8::bf16_t*)(ws + WS_Z), NZ, (float*)(ws + WS_ZSLAB), (const float*)(ws + WS_EB), (const float*)(ws + WS_COS), (const float*)(ws + WS_SIN)};
        pg8::gemm_phase<pg8::EpiZ, pg8::SplitOrder, true, true>(lds + RING_OFF, g, S, E);
    }
    SEAM(2);
    if (IN(3)) { for (int rep = 0; rep < REP3A; ++rep) p3_recurrence(args, lds, vcu, G, tid, wave, lane); for (int rep = 0; rep < REP3B; ++rep) p3_decode(args, lds, vcu, G, tid); }
    SEAM(3);
    if (IN(4)) p4_merge(args, lds, vcu, G, gw, NGW, wave, lane);
    SEAM(4);
    if (IN(5)) for (int rep = 0; rep < REP5; ++rep) {
        { pg8::Gemm g{(const pg8::bf16_t*)(ws + WS_MERGED), (const pg8::bf16_t*)(ws + WS_WOUT), MPAD, DM, DM}; pg8::SplitOrder S; S.init(MP / 256, DM / 256, DM / 64, NSPLIT, 1, G, bx);
          pg8::EpiResid E{args.in[I_XP], args.in[I_XS], (float*)(ws + WS_H), (float*)(ws + WS_SLAB2)};
          pg8::gemm_phase<pg8::EpiResid, pg8::SplitOrder, true, true>(lds + RING_OFF, g, S, E); }
        { pg8::Gemm g{(const pg8::bf16_t*)(ws + WS_PB), (const pg8::bf16_t*)(ws + WS_WPP), MPAD, DM, PLE}; pg8::SplitOrder S; S.init(MP / 256, DM / 256, PLE / 64, 1, 0, G, bx);
          pg8::EpiF32 E{(float*)(ws + WS_PP)};
          pg8::gemm_phase<pg8::EpiF32, pg8::SplitOrder, true, true>(lds + RING_OFF, g, S, E); }
    }
    SEAM(5);
    if (IN(6)) for (int rep = 0; rep < REP6; ++rep) p6_norm_bf16(args, lds, vcu, G, gw, NGW, wave, lane);
    SEAM(6);
    if (IN(7)) for (int rep = 0; rep < REP7; ++rep) {
        pg8::Gemm g{(const pg8::bf16_t*)(ws + WS_HN), (const pg8::bf16_t*)(ws + WS_WGATE), MPAD, DM, DM}; pg8::SplitOrder S; S.init(MP / 256, DM / 256, DM / 64, NSPLIT, 1, G, bx);
        pg8::EpiGate E{(const float*)(ws + WS_H), (const float*)(ws + WS_PP), args.out + OUT_Y, (float*)(ws + WS_SLAB2)};
        pg8::gemm_phase<pg8::EpiGate, pg8::SplitOrder, true, true>(lds + RING_OFF, g, S, E);
    }
    SEAM(7);
    if (IN(8)) p8_norm_final(args, lds, vcu, G, gw, NGW, wave, lane);
#undef IN
#undef SEAM
}

extern "C" void kernel_launch(void* const* d_in, const int* in_sizes, int n_in, void* d_out, int out_size, void* d_ws, size_t ws_size, hipStream_t stream) {
    static int grid = 0;
    if (grid == 0) {
        if (n_in != 16 || (size_t)out_size != OUT_END || ws_size < WS_END) { fprintf(stderr, "kernel_launch: unexpected shapes: n_in %d out %d ws %zu (need out %zu ws >= %zu); nothing launched\n", n_in, out_size, ws_size, (size_t)OUT_END, (size_t)WS_END); grid = -1; return; }
        int dev = 0, cus = 0, per_cu = 0;
        if (hipGetDevice(&dev) != hipSuccess || hipDeviceGetAttribute(&cus, hipDeviceAttributeMultiprocessorCount, dev) != hipSuccess) { fprintf(stderr, "kernel_launch: device query failed\n"); grid = -1; return; }
        if (hipFuncSetAttribute((const void*)fwd_kernel, hipFuncAttributeMaxDynamicSharedMemorySize, LDS_BYTES) != hipSuccess) { fprintf(stderr, "kernel_launch: hipFuncSetAttribute(%d B LDS) failed\n", LDS_BYTES); grid = -1; return; }
        if (hipOccupancyMaxActiveBlocksPerMultiprocessor(&per_cu, (const void*)fwd_kernel, NWAVES * 64, LDS_BYTES) != hipSuccess || per_cu < 1) { fprintf(stderr, "kernel_launch: occupancy query says %d blocks/CU; nothing launched\n", per_cu); (void)hipGetLastError(); grid = -1; return; }
        grid = cus;
    }
    if (grid < 0) return;
    if (hipMemsetAsync((char*)d_ws + WS_CTL, 0, CTL_ZERO_BYTES, stream) != hipSuccess) { fprintf(stderr, "kernel_launch: memset failed\n"); return; }
    Args a{};
    for (int i = 0; i < 16; ++i) a.in[i] = (const float*)d_in[i];
    a.out = (float*)d_out; a.ws = (unsigned char*)d_ws;
    if (PROBE_PHASE >= 0) { a.ph_lo = PROBE_PHASE; a.ph_hi = PROBE_PHASE + 1; a.li = 0; hipLaunchKernelGGL(fwd_kernel, dim3(grid), dim3(NWAVES * 64), LDS_BYTES, stream, a);
        (void)hipMemsetAsync((char*)d_ws + WS_CTL, 0, CTL_ZERO_BYTES, stream); }
    for (int li = 0; li < N_LAUNCHES; ++li) {
        a.ph_lo = (N_LAUNCHES == PER_PHASE) ? li : 0; a.ph_hi = (N_LAUNCHES == PER_PHASE) ? li + 1 : PER_PHASE; a.li = li;
        hipLaunchKernelGGL(fwd_kernel, dim3(grid), dim3(NWAVES * 64), LDS_BYTES, stream, a);
        const hipError_t le = hipPeekAtLastError();
        if (le != hipSuccess) { fprintf(stderr, "kernel_launch: launch %d failed: %s\n", li, hipGetErrorName(le)); break; }
    }
}
```

```cpp
#include <hip/hip_runtime.h>
#include <cstdio>
#include <cstdint>
namespace pg8 {
#define PG8_LAS __attribute__((address_space(3)))
typedef unsigned short bf16_t;
typedef short bf16x8 __attribute__((ext_vector_type(8)));
typedef float f32x4 __attribute__((ext_vector_type(4)));
typedef unsigned u32x4 __attribute__((ext_vector_type(4)));
constexpr int BM = 256, BK = 64, HALF = 128, HTB = HALF * BK * 2  , STAGE_BYTES = 8 * HTB, NXCD = 8, WGM = 8;

__host__ __device__ __forceinline__ int lds_byte(int r, int c) { const int st = (r >> 4) * 2 + (c >> 5), rr = r & 15, cc = c & 31, ob = rr * 64 + cc * 2; return st * 1024 + (ob ^ (((ob >> 9) & 1) << 5)); }
__host__ __device__ __forceinline__ void stage_rc(int b, int& R, int& C) { const int st = b / 1024, sb = b % 1024, swz = sb ^ (((sb >> 9) & 1) << 5); R = (st >> 1) * 16 + swz / 64; C = (st & 1) * 32 + (swz % 64) / 2; }
__host__ __device__ __forceinline__ int perm32(int rho) { const int n = rho >> 4, i = rho & 15; return 8 * (i >> 2) + 4 * n + (i & 3); }

struct Unit { int pm, pn, k0, nt, kind; };
struct Gemm { const bf16_t* A; const bf16_t* Bt; int M, N, K; };

struct StaticOrder {
    int nM, nN, nwg, G, c;
    __host__ __device__ void init(int M, int N, int G_, int c_) { nM = M / BM; nN = N / BM; nwg = nM * nN; G = G_; c = c_; }
    __host__ __device__ bool next(int i, Unit& u) const {
        const long L = (long)i * G + c; if (L >= nwg) return false;
        int wgid = (int)L; { const int q = nwg / NXCD, r = nwg % NXCD, xcd = wgid % NXCD, off = wgid / NXCD; wgid = (xcd < r ? xcd * (q + 1) : r * (q + 1) + (xcd - r) * q) + off; }
        const int nig = WGM * nN, gid = wgid / nig, fm = gid * WGM, gsz = (nM - fm) < WGM ? (nM - fm) : WGM;
        u.pm = fm + ((wgid % nig) % gsz); u.pn = (wgid % nig) / gsz; u.k0 = 0; u.nt = 0; u.kind = 0; return true;
    }
    __device__ __forceinline__ void a_ready(const Unit&) const {}
    __device__ __forceinline__ void done(const Unit&) const {}
};
struct SplitOrder {
    int nM, nN, nwg, G, c, npre, nsplit, ntk, prekind;
    __host__ __device__ void init(int nM_, int nN_, int ntk_, int nsplit_, int prekind_, int G_, int c_) { nM = nM_; nN = nN_; nwg = nM * nN; G = G_; c = c_; nsplit = nsplit_; npre = nN_ * nsplit_; ntk = ntk_; prekind = prekind_; }
    __host__ __device__ bool next(int i, Unit& u) const {
        const long L = (long)i * G + c; if (L >= npre + nwg) return false;
        if (L < npre) { const int s = (int)L; u.pm = nM; u.pn = s % nN; const int ks = s / nN; u.nt = ntk / nsplit; u.k0 = ks * u.nt; u.kind = prekind; return true; }
        int wgid = (int)(L - npre); { const int q = nwg / NXCD, r = nwg % NXCD, xcd = wgid % NXCD, off = wgid / NXCD; wgid = (xcd < r ? xcd * (q + 1) : r * (q + 1) + (xcd - r) * q) + off; }
        const int nig = WGM * nN, gid = wgid / nig, fm = gid * WGM, gsz = (nM - fm) < WGM ? (nM - fm) : WGM;
        u.pm = fm + ((wgid % nig) % gsz); u.pn = (wgid % nig) / gsz; u.k0 = 0; u.nt = ntk; u.kind = 0; return true;
    }
    __device__ __forceinline__ void a_ready(const Unit&) const {}
    __device__ __forceinline__ void done(const Unit&) const {}
};

__device__ __forceinline__ unsigned cvt_pk_bf16(float lo, float hi) { unsigned r; asm volatile("v_cvt_pk_bf16_f32 %0, %1, %2" : "=v"(r) : "v"(lo), "v"(hi)); return r; }
template <class Epi, class Sched, bool ALIGN_EPI = false, bool SP2 = false>
__device__ __forceinline__ void gemm_phase(PG8_LAS unsigned char* lds, const Gemm g, const Sched& S, const Epi& E) {
    const int tid = threadIdx.x, wid = __builtin_amdgcn_readfirstlane(tid >> 6), lane = tid & 63, wr = wid >> 2, wc = wid & 3, fr = lane & 15, fq = lane >> 4;
    const int K = g.K;
    unsigned voffA[2], voffB[2];
#pragma unroll
    for (int i = 0; i < 2; ++i) { int R, C; stage_rc(tid * 16 + i * 8192, R, C); const int Rb = Epi::PERM ? ((R & ~31) + perm32(R & 31)) : R;
        voffA[i] = (unsigned)(R * K + C) * 2u; voffB[i] = (unsigned)(Rb * K + C) * 2u; }
    const size_t kstep = (size_t)(BK * 2);
    const size_t hstep = (size_t)HALF * K * 2;
    const size_t tstep = 2 * hstep;
    const unsigned ldsw = (unsigned)wid * 1024u;
    const int aoff = lds_byte(wr * 64 + fr, fq * 8), boff = lds_byte(wc * 32 + fr, fq * 8);
#define PG8_SA(b, h) (((b) * 2 + (h)) * HTB)
#define PG8_SB(b, h) ((4 + (b) * 2 + (h)) * HTB)
#define PG8_STAGE(bufoff, gbase, voff) do { _Pragma("unroll") for (int _i = 0; _i < 2; ++_i) \
        __builtin_amdgcn_global_load_lds((const unsigned*)((const char*)(gbase) + (voff)[_i]), (PG8_LAS unsigned*)(lds + (bufoff) + ldsw + _i * 8192), 16, 0, 0); } while (0)
#define PG8_LDA(dst, b, h) do { _Pragma("unroll") for (int m = 0; m < 4; ++m) _Pragma("unroll") for (int k = 0; k < 2; ++k) dst[m][k] = *(const PG8_LAS bf16x8*)(lds + PG8_SA(b, h) + aoff + m * 2048 + k * 1024); } while (0)
#define PG8_LDB(dst, b, h) do { _Pragma("unroll") for (int n = 0; n < 2; ++n) _Pragma("unroll") for (int k = 0; k < 2; ++k) dst[n][k] = *(const PG8_LAS bf16x8*)(lds + PG8_SB(b, h) + boff + n * 2048 + k * 1024); } while (0)
#define PG8_MMA(ai, bj, At, Bt) do { __builtin_amdgcn_s_setprio(1); _Pragma("unroll") for (int m = 0; m < 4; ++m) _Pragma("unroll") for (int n = 0; n < 2; ++n) _Pragma("unroll") for (int k = 0; k < 2; ++k) \
        acc[ai][bj][m][n] = __builtin_amdgcn_mfma_f32_16x16x32_bf16(Bt[n][k], At[m][k], acc[ai][bj][m][n], 0, 0, 0); __builtin_amdgcn_s_setprio(0); } while (0)
#define PG8_WAIT_V(n) asm volatile("s_waitcnt vmcnt(" #n ")" ::: "memory")
#define PG8_WAIT_L(n) asm volatile("s_waitcnt lgkmcnt(" #n ")" ::: "memory")
#define PG8_BAR __builtin_amdgcn_s_barrier()
#define PG8_SCHED __builtin_amdgcn_sched_barrier(0)
    Unit cur, nxt; int ui = 0;
    if (!S.next(0, cur)) return;
    f32x4 acc[2][2][4][2];
#pragma unroll
    for (int a = 0; a < 2; ++a)
#pragma unroll
        for (int b = 0; b < 2; ++b)
#pragma unroll
            for (int m = 0; m < 4; ++m)
#pragma unroll
                for (int n = 0; n < 2; ++n) acc[a][b][m][n] = (f32x4){0.f, 0.f, 0.f, 0.f};
    bf16x8 At[4][2], B0[2][2], B1[2][2];
    const char* cA = (const char*)g.A + (size_t)cur.pm * tstep + (size_t)cur.k0 * kstep; const char* cB = (const char*)g.Bt + (size_t)cur.pn * tstep + (size_t)cur.k0 * kstep;
    S.a_ready(cur);
    if constexpr (SP2) {
        PG8_STAGE(PG8_SB(0, 0), cB, voffB); PG8_STAGE(PG8_SB(0, 1), cB + hstep, voffB); PG8_STAGE(PG8_SA(0, 0), cA, voffA); PG8_STAGE(PG8_SA(0, 1), cA + hstep, voffA);
        if (wr == 1) PG8_BAR;
        PG8_WAIT_V(2); PG8_BAR;
        PG8_STAGE(PG8_SB(1, 0), cB + kstep, voffB); PG8_STAGE(PG8_SA(1, 0), cA + kstep, voffA); PG8_STAGE(PG8_SB(1, 1), cB + hstep + kstep, voffB);
        PG8_WAIT_V(6); PG8_BAR;
    } else {
        PG8_STAGE(PG8_SB(0, 0), cB, voffB); PG8_STAGE(PG8_SA(0, 0), cA, voffA); PG8_STAGE(PG8_SB(0, 1), cB + hstep, voffB); PG8_STAGE(PG8_SA(0, 1), cA + hstep, voffA);
        if (wr == 1) PG8_BAR;
        PG8_WAIT_V(4); PG8_BAR;
        PG8_STAGE(PG8_SB(1, 0), cB + kstep, voffB); PG8_STAGE(PG8_SA(1, 0), cA + kstep, voffA); PG8_STAGE(PG8_SB(1, 1), cB + hstep + kstep, voffB);
        PG8_WAIT_V(6); PG8_BAR;
    }
    for (;;) {
        const bool has_next = S.next(ui + 1, nxt);
        const char* nA = has_next ? (const char*)g.A + (size_t)nxt.pm * tstep + (size_t)nxt.k0 * kstep : cA; const char* nB = has_next ? (const char*)g.Bt + (size_t)nxt.pn * tstep + (size_t)nxt.k0 * kstep : cB;
        const int nt = cur.nt;
        for (int t = 0; t < nt; t += 2) {
            const bool last = (t == nt - 2);
            const char* a1 = cA + (size_t)(t + 1) * kstep;
            const char* a2 = last ? nA : cA + (size_t)(t + 2) * kstep; const char* b2 = last ? nB : cB + (size_t)(t + 2) * kstep;
            const char* a3 = a2 + kstep; const char* b3 = b2 + kstep;
            if (last && has_next) S.a_ready(nxt);
            if constexpr (SP2) {
            PG8_LDB(B0, 0, 0); PG8_LDB(B1, 0, 1); PG8_SCHED; PG8_LDA(At, 0, 0); PG8_STAGE(PG8_SA(1, 1), a1 + hstep, voffA);
            PG8_WAIT_V(8); PG8_WAIT_L(0); PG8_BAR; PG8_MMA(0, 0, At, B0); PG8_MMA(0, 1, At, B1); PG8_BAR; PG8_SCHED;
            PG8_LDA(At, 0, 1); PG8_STAGE(PG8_SB(0, 0), b2, voffB); PG8_STAGE(PG8_SB(0, 1), b2 + hstep, voffB); PG8_STAGE(PG8_SA(0, 0), a2, voffA);
            PG8_WAIT_V(8); PG8_WAIT_L(0); PG8_BAR; PG8_MMA(1, 0, At, B0); PG8_MMA(1, 1, At, B1); PG8_BAR; PG8_SCHED;
            PG8_LDB(B0, 1, 0); PG8_LDB(B1, 1, 1); PG8_SCHED; PG8_LDA(At, 1, 0); PG8_STAGE(PG8_SA(0, 1), a2 + hstep, voffA);
            PG8_WAIT_V(8); PG8_WAIT_L(0); PG8_BAR; PG8_MMA(0, 0, At, B0); PG8_MMA(0, 1, At, B1); PG8_BAR; PG8_SCHED;
            PG8_LDA(At, 1, 1); PG8_STAGE(PG8_SB(1, 0), b3, voffB); PG8_STAGE(PG8_SB(1, 1), b3 + hstep, voffB); PG8_STAGE(PG8_SA(1, 0), a3, voffA);
            PG8_WAIT_V(8); PG8_WAIT_L(0); PG8_BAR; PG8_MMA(1, 0, At, B0); PG8_MMA(1, 1, At, B1); PG8_BAR; PG8_SCHED;
            } else {
            PG8_LDB(B0, 0, 0); PG8_SCHED; PG8_LDA(At, 0, 0); PG8_STAGE(PG8_SA(1, 1), a1 + hstep, voffA);
            PG8_WAIT_L(8); PG8_BAR; PG8_WAIT_L(0); PG8_MMA(0, 0, At, B0); PG8_BAR; PG8_SCHED;
            PG8_LDB(B1, 0, 1); PG8_STAGE(PG8_SB(0, 0), b2, voffB);
            PG8_BAR; PG8_WAIT_L(0); PG8_MMA(0, 1, At, B1); PG8_BAR;
            PG8_LDA(At, 0, 1); PG8_STAGE(PG8_SA(0, 0), a2, voffA);
            PG8_BAR; PG8_WAIT_L(0); PG8_MMA(1, 0, At, B0); PG8_BAR; PG8_SCHED;
            PG8_STAGE(PG8_SB(0, 1), b2 + hstep, voffB);
            PG8_WAIT_V(6); PG8_BAR; PG8_MMA(1, 1, At, B1); PG8_BAR;
            PG8_LDB(B0, 1, 0); PG8_SCHED; PG8_LDA(At, 1, 0); PG8_STAGE(PG8_SA(0, 1), a2 + hstep, voffA);
            PG8_WAIT_L(8); PG8_BAR; PG8_WAIT_L(0); PG8_MMA(0, 0, At, B0); PG8_BAR; PG8_SCHED;
            PG8_LDB(B1, 1, 1); PG8_STAGE(PG8_SB(1, 0), b3, voffB);
            PG8_BAR; PG8_WAIT_L(0); PG8_MMA(0, 1, At, B1); PG8_BAR;
            PG8_LDA(At, 1, 1); PG8_STAGE(PG8_SA(1, 0), a3, voffA);
            PG8_BAR; PG8_WAIT_L(0); PG8_MMA(1, 0, At, B0); PG8_BAR; PG8_SCHED;
            PG8_STAGE(PG8_SB(1, 1), b3 + hstep, voffB);
            PG8_WAIT_V(6); PG8_BAR; PG8_MMA(1, 1, At, B1); PG8_BAR;
            }
        }
        if constexpr (ALIGN_EPI) { if (wr == 0) PG8_BAR; }
        if constexpr (!Epi::AFTER_DRAIN) { E(acc, cur, wr, wc, fr, fq); S.done(cur); }
        if (!has_next) break;
#pragma unroll
        for (int a = 0; a < 2; ++a)
#pragma unroll
            for (int b = 0; b < 2; ++b)
#pragma unroll
                for (int m = 0; m < 4; ++m)
#pragma unroll
                    for (int n = 0; n < 2; ++n) acc[a][b][m][n] = (f32x4){0.f, 0.f, 0.f, 0.f};
        cur = nxt; cA = nA; cB = nB; ++ui;
        if constexpr (ALIGN_EPI) { if (wr == 1) PG8_BAR; }
    }
    PG8_WAIT_V(0);
    if constexpr (!ALIGN_EPI) { if (wr == 0) PG8_BAR; }
    PG8_BAR;
    if constexpr (Epi::AFTER_DRAIN) { E.fused(acc, cur, wr, wc, fr, fq, lds, wid, lane); S.done(cur); }
#undef PG8_SA
#undef PG8_SB
#undef PG8_STAGE
#undef PG8_LDA
#undef PG8_LDB
#undef PG8_MMA
#undef PG8_WAIT_V
#undef PG8_WAIT_L
#undef PG8_BAR
#undef PG8_SCHED
}
}
namespace pg8 {
struct EpiZ {
    static constexpr bool PERM = true, AFTER_DRAIN = false;
    bf16_t* O; int ldc; float* slab; const float* EB; const float* COS; const float* SIN;
    __device__ __forceinline__ void operator()(const f32x4 (&acc)[2][2][4][2], const Unit& u, int wr, int wc, int fr, int fq) const {
        const int row0 = u.pm * BM + wr * 64 + fr, col0 = u.pn * BM + wc * 32 + 8 * fq;
        if (u.kind == 1) { const int ks = u.k0 / u.nt;
#pragma unroll
            for (int m = 0; m < 4; ++m) { float* sp = slab + (size_t)(ks * 128 + wr * 64 + m * 16 + fr) * ldc + col0;
#pragma unroll
                for (int bj = 0; bj < 2; ++bj) { *(f32x4*)(sp + bj * HALF) = acc[0][bj][m][0]; *(f32x4*)(sp + bj * HALF + 4) = acc[0][bj][m][1]; } }
            return; }
        const int pn = u.pn;
        if (pn < 8) {
            const bool isq = pn < 4; const int ch0 = col0 - (isq ? 0 : 1024);
#pragma unroll
            for (int ai = 0; ai < 2; ++ai)
#pragma unroll
                for (int m = 0; m < 4; ++m) { const int r = row0 + ai * HALF + m * 16; bf16_t* rowp = O + (size_t)r * ldc + col0; const float* ebp = EB + (size_t)r * 1024 + ch0;
#pragma unroll
                    for (int bj = 0; bj < 2; ++bj) { const f32x4 b0 = *(const f32x4*)(ebp + bj * HALF), b1 = *(const f32x4*)(ebp + bj * HALF + 4); f32x4 v0 = acc[ai][bj][m][0], v1 = acc[ai][bj][m][1];
#pragma unroll
                        for (int e = 0; e < 4; ++e) { v0[e] *= isq ? 0.0625f * __expf(b0[e]) : __expf(-b0[e]); v1[e] *= isq ? 0.0625f * __expf(b1[e]) : __expf(-b1[e]); }
                        u32x4 w; w.x = cvt_pk_bf16(v0[0], v0[1]); w.y = cvt_pk_bf16(v0[2], v0[3]); w.z = cvt_pk_bf16(v1[0], v1[1]); w.w = cvt_pk_bf16(v1[2], v1[3]);
                        *(u32x4*)(rowp + bj * HALF) = w; } }
            return; }
        if (pn >= 24 && pn < 40) {
            const bool isq = pn < 32; const int h = isq ? pn - 24 : pn - 32; const int i0 = wc * 32 + 8 * fq;
            const float lg = __logf(1.0f - exp2f(-5.0f - (float)h));
#pragma unroll
            for (int ai = 0; ai < 2; ++ai)
#pragma unroll
                for (int m = 0; m < 4; ++m) { const int r = row0 + ai * HALF + m * 16; bf16_t* rowp = O + (size_t)r * ldc + col0; const int pos = r & 2047; const float t1 = (float)((r & 63) + 1);
                    const float sc = isq ? __expf(lg * t1) : 0.0625f * __expf(-lg * t1);
                    const float* cp = COS + pos * 128 + i0; const float* sp = SIN + pos * 128 + i0;
                    const f32x4 c0 = *(const f32x4*)cp, c1 = *(const f32x4*)(cp + 4), s0 = *(const f32x4*)sp, s1 = *(const f32x4*)(sp + 4);
                    const f32x4 a0 = acc[ai][0][m][0], a1 = acc[ai][0][m][1], b0 = acc[ai][1][m][0], b1 = acc[ai][1][m][1];
                    const f32x4 y00 = (a0 * c0 - b0 * s0) * sc, y01 = (a1 * c1 - b1 * s1) * sc, y10 = (a0 * s0 + b0 * c0) * sc, y11 = (a1 * s1 + b1 * c1) * sc;
                    u32x4 w; w.x = cvt_pk_bf16(y00[0], y00[1]); w.y = cvt_pk_bf16(y00[2], y00[3]); w.z = cvt_pk_bf16(y01[0], y01[1]); w.w = cvt_pk_bf16(y01[2], y01[3]);
                    *(u32x4*)rowp = w;
                    w.x = cvt_pk_bf16(y10[0], y10[1]); w.y = cvt_pk_bf16(y10[2], y10[3]); w.z = cvt_pk_bf16(y11[0], y11[1]); w.w = cvt_pk_bf16(y11[2], y11[3]);
                    *(u32x4*)(rowp + HALF) = w; }
            return; }
#pragma unroll
        for (int ai = 0; ai < 2; ++ai)
#pragma unroll
            for (int m = 0; m < 4; ++m) { bf16_t* rowp = O + (size_t)(row0 + ai * HALF + m * 16) * ldc + col0;
#pragma unroll
                for (int bj = 0; bj < 2; ++bj) { const f32x4 v0 = acc[ai][bj][m][0], v1 = acc[ai][bj][m][1];
                    u32x4 w; w.x = cvt_pk_bf16(v0[0], v0[1]); w.y = cvt_pk_bf16(v0[2], v0[3]); w.z = cvt_pk_bf16(v1[0], v1[1]); w.w = cvt_pk_bf16(v1[2], v1[3]);
                    *(u32x4*)(rowp + bj * HALF) = w; } }
    }
};
struct EpiResid {
    static constexpr bool PERM = false, AFTER_DRAIN = false;
    const float* xp; const float* xs; float* H; float* slab;
    __device__ __forceinline__ void operator()(const f32x4 (&acc)[2][2][4][2], const Unit& u, int wr, int wc, int fr, int fq) const {
        const int row0 = u.pm * BM + wr * 64 + fr, col0 = u.pn * BM + wc * 32 + 4 * fq;
        if (u.kind == 1) { const int ks = u.k0 / u.nt;
#pragma unroll
            for (int m = 0; m < 4; ++m) { float* sp = slab + (size_t)(ks * 128 + wr * 64 + m * 16 + fr) * 2048 + col0;
#pragma unroll
                for (int bj = 0; bj < 2; ++bj)
#pragma unroll
                    for (int n = 0; n < 2; ++n) *(f32x4*)(sp + bj * HALF + n * 16) = acc[0][bj][m][n]; }
            return; }
#pragma unroll
        for (int ai = 0; ai < 2; ++ai)
#pragma unroll
            for (int m = 0; m < 4; ++m) { const int r = row0 + ai * HALF + m * 16;
                const float* xr = r < 8192 ? xp + (size_t)r * 2048 : xs + (size_t)(r - 8192) * 2048; const bool real = r < 8320;
                float* hp = H + (size_t)r * 2048 + col0;
#pragma unroll
                for (int bj = 0; bj < 2; ++bj)
#pragma unroll
                    for (int n = 0; n < 2; ++n) { f32x4 xv = (f32x4){0.f, 0.f, 0.f, 0.f}; if (real) xv = *(const f32x4*)(xr + col0 + bj * HALF + n * 16);
                        *(f32x4*)(hp + bj * HALF + n * 16) = acc[ai][bj][m][n] + xv; } }
    }
};
struct EpiF32 {
    static constexpr bool PERM = false, AFTER_DRAIN = false;
    float* C;
    __device__ __forceinline__ void operator()(const f32x4 (&acc)[2][2][4][2], const Unit& u, int wr, int wc, int fr, int fq) const {
        const int row0 = u.pm * BM + wr * 64 + fr, col0 = u.pn * BM + wc * 32 + 4 * fq;
#pragma unroll
        for (int ai = 0; ai < 2; ++ai)
#pragma unroll
            for (int m = 0; m < 4; ++m) { float* cp = C + (size_t)(row0 + ai * HALF + m * 16) * 2048 + col0;
#pragma unroll
                for (int bj = 0; bj < 2; ++bj)
#pragma unroll
                    for (int n = 0; n < 2; ++n) *(f32x4*)(cp + bj * HALF + n * 16) = acc[ai][bj][m][n]; }
    }
};
struct EpiGate {
    static constexpr bool PERM = false, AFTER_DRAIN = false;
    const float* H; const float* PP; float* out; float* slab;
    __device__ __forceinline__ void operator()(const f32x4 (&acc)[2][2][4][2], const Unit& u, int wr, int wc, int fr, int fq) const {
        const int row0 = u.pm * BM + wr * 64 + fr, col0 = u.pn * BM + wc * 32 + 4 * fq;
        if (u.kind == 1) { const int ks = u.k0 / u.nt;
#pragma unroll
            for (int m = 0; m < 4; ++m) { float* sp = slab + (size_t)(ks * 128 + wr * 64 + m * 16 + fr) * 2048 + col0;
#pragma unroll
                for (int bj = 0; bj < 2; ++bj)
#pragma unroll
                    for (int n = 0; n < 2; ++n) *(f32x4*)(sp + bj * HALF + n * 16) = acc[0][bj][m][n]; }
            return; }
#pragma unroll
        for (int ai = 0; ai < 2; ++ai)
#pragma unroll
            for (int m = 0; m < 4; ++m) { const int r = row0 + ai * HALF + m * 16; if (r < 8320) { const size_t off = (size_t)r * 2048 + col0;
#pragma unroll
                for (int bj = 0; bj < 2; ++bj)
#pragma unroll
                    for (int n = 0; n < 2; ++n) { const f32x4 hv = *(const f32x4*)(H + off + bj * HALF + n * 16), pv = *(const f32x4*)(PP + off + bj * HALF + n * 16), a = acc[ai][bj][m][n]; f32x4 o;
#pragma unroll
                        for (int e = 0; e < 4; ++e) o[e] = hv[e] + pv[e] / (1.f + __expf(-a[e]));
                        *(f32x4*)(out + off + bj * HALF + n * 16) = o; } } }
    }
};
}
constexpr int NWAVES = 8;
#ifndef MK_N_LAUNCHES
#define MK_N_LAUNCHES 1
#endif
constexpr int N_LAUNCHES = MK_N_LAUNCHES;
constexpr int PER_PHASE = 9;
constexpr int PROBE_PHASE = -1;
constexpr int REP0 = 1, REP1 = 1, REP3A = 1, REP3B = 1, REP4 = 1, REP5 = 1, REP6 = 1, REP7 = 1;
constexpr int DM = 2048, MP = 8192, MS = 128, MR = 8320, MPAD = 8448, SEQ = 2048;
constexpr int NIN = 18448, NZ = 18432, PLE = 256;
constexpr int ZQA = 0, ZKA = 1024, ZVA = 2048, ZGA = 4096, ZQB = 6144, ZKB = 8192, ZVB = 10240, ZGB = 12288, ZMA = 14336, ZMB = 16384;
constexpr int SRC_RA = 6144;
constexpr float EPS = 1e-6f;
constexpr size_t MiB = 1u << 20;
constexpr size_t WS_CTL = 0, CTL_ZERO_BYTES = 64 * 1024;
constexpr size_t WS_WIN = 1 * MiB;
constexpr size_t WS_WOUT = 73 * MiB;
constexpr size_t WS_WGATE = 81 * MiB;
constexpr size_t WS_WPP = 89 * MiB;
constexpr size_t WS_U = 90 * MiB;
constexpr size_t WS_PB = 123 * MiB;
constexpr size_t WS_RA = 128 * MiB;
constexpr size_t WS_COS = 129 * MiB;
constexpr size_t WS_SIN = 130 * MiB + 65536;
constexpr size_t WS_DLAST = 132 * MiB;
constexpr size_t WS_Z = 133 * MiB;
constexpr size_t WS_OA = 430 * MiB;
constexpr size_t WS_OB = 496 * MiB;
constexpr size_t WS_MERGED = 562 * MiB;
constexpr size_t WS_H = 595 * MiB;
constexpr size_t WS_PP = 661 * MiB;
constexpr size_t WS_HN = 727 * MiB;
constexpr size_t WS_ZSLAB = 760 * MiB;
constexpr size_t WS_SLAB2 = 832 * MiB;
constexpr size_t WS_EB = 840 * MiB;
constexpr size_t WS_END = 872 * MiB;
constexpr int NSPLIT = 8;
static_assert(WS_Z + (size_t)MPAD * NZ * 2 <= WS_OA && WS_WIN + (size_t)NZ * DM * 2 <= WS_WOUT, "ws map");
constexpr size_t OUT_Y = 0, OUT_GLA_P = (size_t)MR * DM, OUT_RET_P = OUT_GLA_P + 2097152, OUT_GLA_S = OUT_RET_P + 2097152, OUT_RET_S = OUT_GLA_S + 67108864, OUT_END = OUT_RET_S + 67108864;
constexpr int CW_BAR = 4096;
constexpr int RING_OFF = 0, RING_BYTES = 131072;
constexpr int LDS_BYTES = 160 * 1024;
constexpr int MISC_OFF = LDS_BYTES - 256;
#define GAS __attribute__((address_space(1)))
#define LAS __attribute__((address_space(3)))
typedef unsigned short bf16;
typedef unsigned v4u __attribute__((ext_vector_type(4)));
typedef unsigned v2u __attribute__((ext_vector_type(2)));
typedef float f32x4 __attribute__((ext_vector_type(4)));
typedef short bf16x8 __attribute__((ext_vector_type(8)));
typedef GAS unsigned gu32;
#define LDS_WAIT() asm volatile("s_waitcnt lgkmcnt(0)" ::: "memory")
__device__ __forceinline__ unsigned f2bf(float f) { unsigned u = __builtin_bit_cast(unsigned, f); return (u + 0x7fffu + ((u >> 16) & 1u)) >> 16; }
__device__ __forceinline__ unsigned pk2(float lo, float hi) { return f2bf(lo) | (f2bf(hi) << 16); }
__device__ __forceinline__ float bf2f(unsigned b) { return __builtin_bit_cast(float, b << 16); }
__device__ __forceinline__ float bflo(unsigned w) { return __builtin_bit_cast(float, w << 16); }
__device__ __forceinline__ float bfhi(unsigned w) { return __builtin_bit_cast(float, w & 0xffff0000u); }
__device__ __forceinline__ float sigm(float x) { return 1.f / (1.f + __expf(-x)); }
__device__ __forceinline__ float log_sigmoid(float x) { return fminf(x, 0.f) - log1pf(expf(-fabsf(x))); }
__device__ __forceinline__ float wave_sum(float v) {
#pragma unroll
    for (int o = 1; o < 64; o <<= 1) v += __shfl_xor(v, o);
    return v;
}
#define XB_SPIN_CAP_OVERRIDE 1
#define XB_TMO      128
#define XB_XCNT(j)  (256  + 64 * (j))
#define XB_XSUB(j)  (1280 + 64 * (j))
#define XB_XGEN(j)  (2304 + 64 * (j))
#define XB_TOP      3328
#define XB_TOPGEN   3392
#define XCD_BAR_WORDS 3456
#define XB_SPIN_CAP (1u << 23)

__device__ __forceinline__ unsigned xb_ld(unsigned* p)              { return __hip_atomic_load(p, __ATOMIC_RELAXED, __HIP_MEMORY_SCOPE_AGENT); }
__device__ __forceinline__ unsigned xb_add(unsigned* p, unsigned v) { return __hip_atomic_fetch_add(p, v, __ATOMIC_RELAXED, __HIP_MEMORY_SCOPE_AGENT); }
__device__ __forceinline__ unsigned xb_xcc_id() { return (unsigned)__builtin_amdgcn_s_getreg((3 << 11) | 20) & 0xFu; }
#define XB_SPIN(cond, bar) do { unsigned _sp = 0; while (cond) { __builtin_amdgcn_s_sleep(1); \
    if ((++_sp & 255u) == 0u) { if (xb_ld(&(bar)[XB_TMO])) break; if (_sp > XB_SPIN_CAP) { atomicAdd(&(bar)[XB_TMO], 1u); break; } } } } while (0)

struct XcdBarrier {
    unsigned* bar; unsigned x;
    volatile LAS unsigned* st;
};

__device__ __forceinline__ XcdBarrier xcd_barrier_post(unsigned* bar, volatile LAS unsigned* st) {
    XcdBarrier b; b.bar = bar; b.x = xb_xcc_id(); b.st = st;
    if (threadIdx.x == 0) (void)xb_add(&bar[XB_XCNT(b.x)], 1u);
    return b;
}
__device__ __forceinline__ void xcd_barrier_complete(unsigned* bar, unsigned x, unsigned& nloc, unsigned& nx) {
    const unsigned G = gridDim.x * gridDim.y * gridDim.z;
    unsigned sum, cnt, mine, sp = 0u;
    for (;;) {
        sum = 0u; cnt = 0u; mine = 0u;
#pragma unroll
        for (unsigned j = 0; j < 16; ++j) { const unsigned c = xb_ld(&bar[XB_XCNT(j)]); sum += c; cnt += (c > 0u) ? 1u : 0u; mine = (j == x) ? c : mine; }
        if (sum == G) break;
        __builtin_amdgcn_s_sleep(1);
        if ((++sp & 255u) == 0u) { if (xb_ld(&bar[XB_TMO])) break; if (sp > XB_SPIN_CAP) { atomicAdd(&bar[XB_TMO], 1u); break; } }
    }
    nloc = mine > 0u ? mine : 1u; nx = cnt > 0u ? cnt : 1u;
}

__device__ __forceinline__ void xcd_barrier(const XcdBarrier& b) {
    asm volatile("s_waitcnt vmcnt(0)" ::: "memory");
    __syncthreads();
    if (threadIdx.x == 0) {
        unsigned* bar = b.bar;
        __builtin_amdgcn_s_waitcnt(0);
        unsigned nloc = b.st[0], nx = b.st[1];
        if (nloc == 0u) { xcd_barrier_complete(bar, b.x, nloc, nx); b.st[0] = nloc; b.st[1] = nx; }
        const unsigned old = xb_add(&bar[XB_XSUB(b.x)], 1u);
        const unsigned gen = old / nloc;
        if (old + 1u == (gen + 1u) * nloc) {
            __builtin_amdgcn_fence(__ATOMIC_RELEASE, "agent");
            asm volatile("s_waitcnt vmcnt(0)" ::: "memory");
            const unsigned og = xb_add(&bar[XB_TOP], 1u);
            const unsigned tg = og / nx;
            if (og + 1u == (tg + 1u) * nx) xb_add(&bar[XB_TOPGEN], 1u);
            else XB_SPIN(xb_ld(&bar[XB_TOPGEN]) == tg, bar);
            __builtin_amdgcn_fence(__ATOMIC_ACQUIRE, "agent");
            xb_add(&bar[XB_XGEN(b.x)], 1u);
            asm volatile("s_waitcnt vmcnt(0)" ::: "memory");
        } else {
            XB_SPIN(xb_ld(&bar[XB_XGEN(b.x)]) == gen, bar);
            __builtin_amdgcn_fence(__ATOMIC_ACQUIRE, "agent");
            asm volatile("s_waitcnt vmcnt(0)" ::: "memory");
        }
    }
    __syncthreads();
}
struct Args { const float* in[16]; float* out; unsigned char* ws; int ph_lo, ph_hi, li, pad; };
enum { I_XP = 0, I_XS, I_SGLA, I_SRET, I_PP, I_PS, I_NMIX, I_WIN, I_WUP, I_BGLA, I_GNORM, I_WOUT, I_NPLE, I_WGATE, I_WPP, I_NFIN };

__device__ __forceinline__ void p0_transpose_item(const float* W, int K, int Nsrc, int nblk, bf16* WT, LAS float* scr, int item, int lane, int gap_at) {
    const int kb = item / nblk, nb = item % nblk, k0 = 64 * kb, n0 = 64 * nb, ns = n0 + (n0 >= gap_at ? 16 : 0);
    f32x4 v[16];
#pragma unroll
    for (int i = 0; i < 16; ++i) v[i] = *(const f32x4*)(W + (size_t)(k0 + 4 * i + (lane >> 4)) * Nsrc + ns + 4 * (lane & 15));
#pragma unroll
    for (int i = 0; i < 16; ++i) { LAS float* d = scr + (4 * i + (lane >> 4)) * 65 + 4 * (lane & 15); d[0] = v[i].x; d[1] = v[i].y; d[2] = v[i].z; d[3] = v[i].w; }
    LDS_WAIT(); asm volatile("" ::: "memory");
    const int c = lane & 7;
#pragma unroll
    for (int j = 0; j < 8; ++j) { const int n = (lane >> 3) + 8 * j; const LAS float* s = scr + (8 * c) * 65 + n;
        v4u o; o.x = pk2(s[0 * 65], s[1 * 65]); o.y = pk2(s[2 * 65], s[3 * 65]); o.z = pk2(s[4 * 65], s[5 * 65]); o.w = pk2(s[6 * 65], s[7 * 65]);
        *(GAS v4u*)(WT + (size_t)(n0 + n) * K + k0 + 8 * c) = o; }
    LDS_WAIT(); asm volatile("" ::: "memory");
}
__device__ __forceinline__ const float* xrow_ptr(const Args& a, int r) { return r < MP ? a.in[I_XP] + (size_t)r * DM : a.in[I_XS] + (size_t)(r - MP) * DM; }

__device__ __forceinline__ void p0_rows(const Args& a, LAS unsigned char* lds, int gw, int NGW, int tid, int lane) {
    unsigned char* ws = a.ws;
    LAS float* wrt = (LAS float*)lds;
    {
#pragma unroll
        for (int i = 0; i < 4; ++i) { const int k = tid + 512 * i; const f32x4* wp = (const f32x4*)(a.in[I_WIN] + (size_t)k * NIN + SRC_RA);
#pragma unroll
            for (int q4 = 0; q4 < 4; ++q4) { const f32x4 w = wp[q4];
#pragma unroll
                for (int t = 0; t < 4; ++t) wrt[(q4 * 4 + t) * 2048 + k] = w[t]; } }
        __syncthreads();
    }
    {
        const float* g = a.in[I_NMIX]; bf16* U = (bf16*)(ws + WS_U); float* RA = (float*)(ws + WS_RA);
        for (int rp = gw; rp < MR / 2; rp += NGW) {
            const int r0 = 2 * rp;
            const f32x4* x0 = (const f32x4*)xrow_ptr(a, r0) + lane; const f32x4* x1 = (const f32x4*)xrow_ptr(a, r0 + 1) + lane;
            float s0 = 0.f, s1 = 0.f;
#pragma unroll
            for (int j = 0; j < 8; ++j) { const f32x4 p = x0[64 * j], q = x1[64 * j];
                s0 += (p.x * p.x + p.y * p.y) + (p.z * p.z + p.w * p.w); s1 += (q.x * q.x + q.y * q.y) + (q.z * q.z + q.w * q.w); }
            const float rs0 = rsqrtf(wave_sum(s0) * (1.f / DM) + EPS), rs1 = rsqrtf(wave_sum(s1) * (1.f / DM) + EPS);
            float acc0[16], acc1[16];
#pragma unroll
            for (int q = 0; q < 16; ++q) { acc0[q] = 0.f; acc1[q] = 0.f; }
            unsigned long long* o0 = (unsigned long long*)(U + (size_t)r0 * DM) + lane; unsigned long long* o1 = (unsigned long long*)(U + (size_t)(r0 + 1) * DM) + lane;
#pragma unroll 1
            for (int j = 0; j < 8; ++j) {
                const f32x4 gv = *((const f32x4*)g + lane + 64 * j);
                const f32x4 u0 = x0[64 * j] * rs0 * gv, u1 = x1[64 * j] * rs1 * gv;
                o0[64 * j] = (unsigned long long)pk2(u0.x, u0.y) | ((unsigned long long)pk2(u0.z, u0.w) << 32);
                o1[64 * j] = (unsigned long long)pk2(u1.x, u1.y) | ((unsigned long long)pk2(u1.z, u1.w) << 32);
#pragma unroll
                for (int q = 0; q < 16; ++q) { const f32x4 w = *(const LAS f32x4*)(wrt + q * 2048 + 256 * j + 4 * lane);
                    acc0[q] += (u0.x * w.x + u0.y * w.y) + (u0.z * w.z + u0.w * w.w); acc1[q] += (u1.x * w.x + u1.y * w.y) + (u1.z * w.z + u1.w * w.w); }
            }
#pragma unroll
            for (int q = 0; q < 16; ++q) { acc0[q] = wave_sum(acc0[q]); acc1[q] = wave_sum(acc1[q]); }
            if (lane < 16) { float s = 0.f, t = 0.f;
#pragma unroll
                for (int q = 0; q < 16; ++q) { s = (lane == q) ? acc0[q] : s; t = (lane == q) ? acc1[q] : t; }
                RA[(size_t)r0 * 16 + lane] = s; RA[(size_t)(r0 + 1) * 16 + lane] = t; }
        }
    }
    {
        bf16* PB = (bf16*)(ws + WS_PB); const int tid = gw * 64 + lane, NT = NGW * 64;
        for (int i = tid; i < MR * (PLE / 4); i += NT) { const int r = i / (PLE / 4), c4 = i % (PLE / 4);
            const float* src = r < MP ? a.in[I_PP] + (size_t)r * PLE : a.in[I_PS] + (size_t)(r - MP) * PLE;
            const f32x4 v = *((const f32x4*)src + c4);
            *((unsigned long long*)(PB + (size_t)r * PLE) + c4) = (unsigned long long)pk2(v.x, v.y) | ((unsigned long long)pk2(v.z, v.w) << 32); }
        float* CT = (float*)(ws + WS_COS); float* ST = (float*)(ws + WS_SIN);
        for (int i = tid; i < 2049 * 128; i += NT) { const int pr = i >> 7, ii = i & 127; const float pos = pr == 2048 ? 16384.f : (float)pr;
            const float e = (float)ii / 127.0f; const float inv = 1.0f / powf(10000.0f, e); const float ang = pos * inv;
            const double rev = (double)ang * 0.15915494309189533577; const float fr = (float)(rev - __builtin_rint(rev));
            CT[i] = __builtin_amdgcn_cosf(fr); ST[i] = __builtin_amdgcn_sinf(fr); }
    }
}
__device__ __forceinline__ void p1_prep(const Args& a, LAS unsigned char* lds, int vcu, int G, int gw, int NGW, int tid, int wave, int lane) {
    unsigned char* ws = a.ws;
    {
        const float* RA = (const float*)(ws + WS_RA); float* EB = (float*)(ws + WS_EB); float* DL = (float*)(ws + WS_DLAST); const float* wup = a.in[I_WUP]; const float* bg = a.in[I_BGLA];
        for (int it = vcu; it < 256; it += G) { const int g = it >> 1, c = (it & 1) * 512 + tid;
            float w[16];
#pragma unroll
            for (int j = 0; j < 16; ++j) w[j] = wup[j * 1024 + c];
            const float bias = bg[c]; float bc = 0.f;
#pragma unroll 4
            for (int t = 0; t < 64; ++t) { const int row = g * 64 + t; const float* ra = RA + (size_t)row * 16; float x = bias;
#pragma unroll
                for (int j = 0; j < 16; ++j) x += ra[j] * w[j];
                bc += (fminf(x, 0.f) - __logf(1.0f + __expf(-fabsf(x)))) * (1.f / 16.f);
                EB[(size_t)row * 1024 + c] = bc; }
            DL[(size_t)g * 1024 + c] = __expf(bc); }
    }
    {
        f32x4* oa = (f32x4*)((float*)(ws + WS_OA) + (size_t)MP * DM); f32x4* ob = (f32x4*)((float*)(ws + WS_OB) + (size_t)MP * DM);
        for (int i = vcu * 512 + tid; i < MS * DM / 4; i += G * 512) { oa[i] = (f32x4){0.f, 0.f, 0.f, 0.f}; ob[i] = (f32x4){0.f, 0.f, 0.f, 0.f}; }
    }
    LAS float* scr = (LAS float*)(lds + RING_OFF + wave * 16896);
    constexpr int I_IN = (DM / 64) * (NZ / 64), I_O = (DM / 64) * (DM / 64), I_G = I_O, I_P = (PLE / 64) * (DM / 64);
    constexpr int NITEMS = I_IN + I_O + I_G + I_P;
    for (int it = gw; it < NITEMS; it += NGW) {
        int r = it;
        if (r < I_IN) { p0_transpose_item(a.in[I_WIN], DM, NIN, NZ / 64, (bf16*)(ws + WS_WIN), scr, r, lane, SRC_RA); continue; } r -= I_IN;
        if (r < I_O) { p0_transpose_item(a.in[I_WOUT], DM, DM, DM / 64, (bf16*)(ws + WS_WOUT), scr, r, lane, 1 << 30); continue; } r -= I_O;
        if (r < I_G) { p0_transpose_item(a.in[I_WGATE], DM, DM, DM / 64, (bf16*)(ws + WS_WGATE), scr, r, lane, 1 << 30); continue; } r -= I_G;
        p0_transpose_item(a.in[I_WPP], PLE, DM, DM / 64, (bf16*)(ws + WS_WPP), scr, r, lane, 1 << 30);
    }
}
constexpr int QS_STR = 528, KT_STR = 144;
constexpr int R_QS = 0, R_KS = 33792, R_KT = 67584, R_VT = 104448, R_AS = 113664, R_ST = 122880, R_END = 156672;
static_assert(R_END <= MISC_OFF, "recurrence LDS map");
__device__ __forceinline__ bf16x8 ldfrag(const LAS unsigned char* p) { return *(const LAS bf16x8*)p; }
__device__ __forceinline__ float slab_sum(const float* SL, int ld, int b, int col) { float s = 0.f;
#pragma unroll
    for (int ks = 0; ks < NSPLIT; ++ks) s += SL[(size_t)(ks * 128 + b) * ld + col];
    return s; }
__device__ __forceinline__ f32x4 slab_sum4(const float* SL, int ld, int b, int col) { f32x4 s = (f32x4){0.f, 0.f, 0.f, 0.f};
#pragma unroll
    for (int ks = 0; ks < NSPLIT; ++ks) s += *(const f32x4*)(SL + (size_t)(ks * 128 + b) * ld + col);
    return s; }
__device__ __forceinline__ void p3_recurrence(const Args& a, LAS unsigned char* lds, int vcu, int G, int tid, int wave, int lane) {
    unsigned char* ws = a.ws; const bf16* Z = (const bf16*)(ws + WS_Z); const float* DL = (const float*)(ws + WS_DLAST);
    const int fr = lane & 15, fq = lane >> 4;
    for (int item = vcu; item < 256; item += G) {
        const bool gla = item < 128; const int it = gla ? item : item - 128;
        const int b = it >> 5, h = gla ? (it >> 3) & 3 : (it >> 2) & 7, ds = gla ? it & 7 : it & 3;
        const int dv = gla ? 512 : 256, nh = gla ? 4 : 8;
        const int cq = (gla ? ZQA : ZQB) + h * 256, ck = (gla ? ZKA : ZKB) + h * 256, cv = (gla ? ZVA : ZVB) + h * dv + ds * 64;
        float* O = (float*)(ws + (gla ? WS_OA : WS_OB)); const int ocol = h * dv + ds * 64;
        const float lgam = logf(1.0f - exp2f(-5.0f - (float)h)); const float dret = expf(64.f * lgam);
        f32x4 sacc[2][4];
#pragma unroll
        for (int ci = 0; ci < 2; ++ci)
#pragma unroll
            for (int di = 0; di < 4; ++di) sacc[ci][di] = (f32x4){0.f, 0.f, 0.f, 0.f};
        for (int i = tid; i < 33792 / 16; i += 512) *(LAS v4u*)(lds + R_ST + i * 16) = (v4u){0u, 0u, 0u, 0u};
        v4u pq[4], pk[4], pt[4], pv; f32x4 po[2] = {(f32x4){0.f, 0.f, 0.f, 0.f}, (f32x4){0.f, 0.f, 0.f, 0.f}};
#define P3_LOAD(nn) do { const int r0_ = b * SEQ + (nn) * 64; \
            _Pragma("unroll") for (int i = 0; i < 4; ++i) { const int p = tid + 512 * i, row = p >> 5, pc = p & 31; \
                pq[i] = *(const v4u*)(Z + (size_t)(r0_ + row) * NZ + cq + pc * 8); pk[i] = *(const v4u*)(Z + (size_t)(r0_ + row) * NZ + ck + pc * 8); } \
            _Pragma("unroll") for (int i = 0; i < 4; ++i) { const int p = tid + 512 * i, s = p & 63, pc = p >> 6; pt[i] = *(const v4u*)(Z + (size_t)(r0_ + s) * NZ + ck + pc * 8); } \
            { const int s = tid & 63, pc = tid >> 6; pv = *(const v4u*)(Z + (size_t)(r0_ + s) * NZ + cv + pc * 8); } } while (0)
        P3_LOAD(0);
        for (int n = 0; n < 32; ++n) {
            const int r0 = b * SEQ + n * 64;
#pragma unroll
            for (int i = 0; i < 4; ++i) { const int p = tid + 512 * i, row = p >> 5, pc = p & 31;
                *(LAS v4u*)(lds + R_QS + row * QS_STR + pc * 16) = pq[i]; *(LAS v4u*)(lds + R_KS + row * QS_STR + pc * 16) = pk[i]; }
#pragma unroll
            for (int i = 0; i < 4; ++i) { const int p = tid + 512 * i, s = p & 63, pc = p >> 6; const v4u vk = pt[i];
                LAS unsigned short* kt = (LAS unsigned short*)(lds + R_KT + (pc * 8) * KT_STR + s * 2);
                kt[0 * (KT_STR / 2)] = (unsigned short)vk.x; kt[1 * (KT_STR / 2)] = (unsigned short)(vk.x >> 16); kt[2 * (KT_STR / 2)] = (unsigned short)vk.y; kt[3 * (KT_STR / 2)] = (unsigned short)(vk.y >> 16);
                kt[4 * (KT_STR / 2)] = (unsigned short)vk.z; kt[5 * (KT_STR / 2)] = (unsigned short)(vk.z >> 16); kt[6 * (KT_STR / 2)] = (unsigned short)vk.w; kt[7 * (KT_STR / 2)] = (unsigned short)(vk.w >> 16); }
            { const int s = tid & 63, pc = tid >> 6; const v4u vv = pv;
                LAS unsigned short* vt = (LAS unsigned short*)(lds + R_VT + (pc * 8) * KT_STR + s * 2);
                vt[0 * (KT_STR / 2)] = (unsigned short)vv.x; vt[1 * (KT_STR / 2)] = (unsigned short)(vv.x >> 16); vt[2 * (KT_STR / 2)] = (unsigned short)vv.y; vt[3 * (KT_STR / 2)] = (unsigned short)(vv.y >> 16);
                vt[4 * (KT_STR / 2)] = (unsigned short)vv.z; vt[5 * (KT_STR / 2)] = (unsigned short)(vv.z >> 16); vt[6 * (KT_STR / 2)] = (unsigned short)vv.w; vt[7 * (KT_STR / 2)] = (unsigned short)(vv.w >> 16); }
            __syncthreads();
            {
                const int rp = (n > 0) ? r0 - 64 : r0;
#pragma unroll
                for (int dj = 0; dj < 2; ++dj)
#pragma unroll
                    for (int e = 0; e < 4; ++e) O[(size_t)(rp + (wave >> 1) * 16 + fq * 4 + e) * DM + ocol + (2 * (wave & 1) + dj) * 16 + fr] = po[dj][e]; }
            f32x4 dlv[2];
#pragma unroll
            for (int ci = 0; ci < 2; ++ci) { const int c0 = (2 * wave + ci) * 16 + fq * 4;
                const f32x4 ld = *(const f32x4*)(DL + (size_t)(b * 32 + n) * 1024 + (h & 3) * 256 + c0);
                dlv[ci] = gla ? ld : (f32x4){dret, dret, dret, dret}; }
            P3_LOAD(n + 1 < 32 ? n + 1 : 31);
            const int ti = wave >> 1, hp = wave & 1;
            f32x4 accA[2], accO[2];
#pragma unroll
            for (int j = 0; j < 2; ++j) { accA[j] = (f32x4){0.f, 0.f, 0.f, 0.f}; accO[j] = (f32x4){0.f, 0.f, 0.f, 0.f}; }
            const bool needA0 = (2 * hp) <= ti, needA1 = (2 * hp + 1) <= ti;
#define P3_QK_LOOP(NA) do { _Pragma("unroll") for (int kk = 0; kk < 8; ++kk) { const int kb = (kk * 32 + fq * 8) * 2; \
                const bf16x8 af = ldfrag(lds + R_QS + (ti * 16 + fr) * QS_STR + kb); \
                const bf16x8 s0 = ldfrag(lds + R_ST + ((2 * hp) * 16 + fr) * QS_STR + kb), s1 = ldfrag(lds + R_ST + ((2 * hp + 1) * 16 + fr) * QS_STR + kb); \
                accO[0] = __builtin_amdgcn_mfma_f32_16x16x32_bf16(af, s0, accO[0], 0, 0, 0); accO[1] = __builtin_amdgcn_mfma_f32_16x16x32_bf16(af, s1, accO[1], 0, 0, 0); \
                if (NA >= 1) { const bf16x8 k0f = ldfrag(lds + R_KS + ((2 * hp) * 16 + fr) * QS_STR + kb); accA[0] = __builtin_amdgcn_mfma_f32_16x16x32_bf16(af, k0f, accA[0], 0, 0, 0); } \
                if (NA >= 2) { const bf16x8 k1f = ldfrag(lds + R_KS + ((2 * hp + 1) * 16 + fr) * QS_STR + kb); accA[1] = __builtin_amdgcn_mfma_f32_16x16x32_bf16(af, k1f, accA[1], 0, 0, 0); } } } while (0)
            if (needA1) P3_QK_LOOP(2); else if (needA0) P3_QK_LOOP(1); else P3_QK_LOOP(0);
#pragma unroll
            for (int sj = 0; sj < 2; ++sj) { const int s = (2 * hp + sj) * 16 + fr;
#pragma unroll
                for (int e = 0; e < 4; ++e) { const int t = ti * 16 + fq * 4 + e; const float v = (s <= t) ? accA[sj][e] : 0.f;
                    *(LAS unsigned short*)(lds + R_AS + t * KT_STR + s * 2) = (unsigned short)f2bf(v); } }
            __syncthreads();
#pragma unroll
            for (int kk = 0; kk < 2; ++kk) if (kk * 32 <= ti * 16 + 15) { const int kb = (kk * 32 + fq * 8) * 2;
                const bf16x8 af = ldfrag(lds + R_AS + (ti * 16 + fr) * KT_STR + kb);
                const bf16x8 v0 = ldfrag(lds + R_VT + ((2 * hp) * 16 + fr) * KT_STR + kb), v1 = ldfrag(lds + R_VT + ((2 * hp + 1) * 16 + fr) * KT_STR + kb);
                accO[0] = __builtin_amdgcn_mfma_f32_16x16x32_bf16(af, v0, accO[0], 0, 0, 0); accO[1] = __builtin_amdgcn_mfma_f32_16x16x32_bf16(af, v1, accO[1], 0, 0, 0); }
            po[0] = accO[0]; po[1] = accO[1];
#pragma unroll
            for (int ci = 0; ci < 2; ++ci) { const int ct = 2 * wave + ci;
#pragma unroll
                for (int kk = 0; kk < 2; ++kk) { const bf16x8 af = ldfrag(lds + R_KT + (ct * 16 + fr) * KT_STR + (kk * 32 + fq * 8) * 2);
#pragma unroll
                    for (int di = 0; di < 4; ++di) { const bf16x8 bfm = ldfrag(lds + R_VT + (di * 16 + fr) * KT_STR + (kk * 32 + fq * 8) * 2);
                        sacc[ci][di] = __builtin_amdgcn_mfma_f32_16x16x32_bf16(af, bfm, sacc[ci][di], 0, 0, 0); } } }
            __syncthreads();
#pragma unroll
            for (int ci = 0; ci < 2; ++ci) { const int c0 = (2 * wave + ci) * 16 + fq * 4; const f32x4 dl = dlv[ci];
#pragma unroll
                for (int di = 0; di < 4; ++di) { sacc[ci][di] = sacc[ci][di] * dl; const f32x4 v = sacc[ci][di];
                    v2u w; w.x = pk2(v[0], v[1]); w.y = pk2(v[2], v[3]);
                    *(LAS v2u*)(lds + R_ST + (di * 16 + fr) * QS_STR + c0 * 2) = w; } }
        }
#pragma unroll
        for (int dj = 0; dj < 2; ++dj)
#pragma unroll
            for (int e = 0; e < 4; ++e) O[(size_t)(b * SEQ + 31 * 64 + (wave >> 1) * 16 + fq * 4 + e) * DM + ocol + (2 * (wave & 1) + dj) * 16 + fr] = po[dj][e];
        __syncthreads();
#undef P3_LOAD
#undef P3_QK_LOOP
        float* SO = a.out + (gla ? OUT_GLA_P : OUT_RET_P) + (size_t)(b * nh + h) * 256 * dv + ds * 64;
#pragma unroll
        for (int ci = 0; ci < 2; ++ci)
#pragma unroll
            for (int di = 0; di < 4; ++di)
#pragma unroll
                for (int e = 0; e < 4; ++e) SO[(size_t)((2 * wave + ci) * 16 + fq * 4 + e) * dv + di * 16 + fr] = sacc[ci][di][e];
    }
}

typedef short v4i16_t __attribute__((ext_vector_type(4)));
__device__ __forceinline__ bf16x8 ld_tr_frag(const LAS unsigned char* tile, int rs, int ks, int ct, int lane) {
    const int g = lane >> 4, q = (lane >> 2) & 3, p = lane & 3;
    const LAS unsigned char* a0 = tile + (32 * ks + 8 * g + q) * rs + (16 * ct + 4 * p) * 2;
    const v4i16_t lo = __builtin_amdgcn_ds_read_tr16_b64_v4i16((LAS v4i16_t*)a0), hi = __builtin_amdgcn_ds_read_tr16_b64_v4i16((LAS v4i16_t*)(a0 + 4 * rs));
    return (bf16x8){lo.x, lo.y, lo.z, lo.w, hi.x, hi.y, hi.z, hi.w};
}
constexpr int VS_STR = 144;
constexpr int R_DEC = R_END;
static_assert(R_DEC + 2 * 3072 <= MISC_OFF, "decode vectors fit above the recurrence tiles");
__device__ __forceinline__ void p3_fused(const Args& a, LAS unsigned char* lds, int vcu, int tid, int wave, int lane) {
    const int G = 256;
    const float* ZS = (const float*)(a.ws + WS_ZSLAB); const float* RA = (const float*)(a.ws + WS_RA); const float* CT = (const float*)(a.ws + WS_COS) + 2048 * 128; const float* ST = (const float*)(a.ws + WS_SIN) + 2048 * 128;
    const float* sgla = a.in[I_SGLA]; const float* sret = a.in[I_SRET];
    asm volatile("" : "+s"(sgla), "+s"(sret));
    f32x4 dsv[8]; f32x4 doacc = (f32x4){0.f, 0.f, 0.f, 0.f}, dv4 = (f32x4){0.f, 0.f, 0.f, 0.f};
    const float* dSin = nullptr; float* dSout = nullptr; float* dSoutPrev = nullptr; float* dOrow = nullptr; float dgam = 0.f; bool dlastPrev = false;
    unsigned char* ws = a.ws; const bf16* Z = (const bf16*)(ws + WS_Z); const float* DL = (const float*)(ws + WS_DLAST);
    const int fr = lane & 15, fq = lane >> 4;
    { const int item = vcu;
        const bool gla = item < 128; const int it = gla ? item : item - 128;
        const int b = it >> 5, h = gla ? (it >> 3) & 3 : (it >> 2) & 7, ds = gla ? it & 7 : it & 3;
        const int dv = gla ? 512 : 256, nh = gla ? 4 : 8;
        const int cq = (gla ? ZQA : ZQB) + h * 256, ck = (gla ? ZKA : ZKB) + h * 256, cv = (gla ? ZVA : ZVB) + h * dv + ds * 64;
        float* O = (float*)(ws + (gla ? WS_OA : WS_OB)); const int ocol = h * dv + ds * 64;
        const float lgam = logf(1.0f - exp2f(-5.0f - (float)h)); const float dret = expf(64.f * lgam);
        f32x4 sacc[2][4];
#pragma unroll
        for (int ci = 0; ci < 2; ++ci)
#pragma unroll
            for (int di = 0; di < 4; ++di) sacc[ci][di] = (f32x4){0.f, 0.f, 0.f, 0.f};
        for (int i = tid; i < 33792 / 16; i += 512) *(LAS v4u*)(lds + R_ST + i * 16) = (v4u){0u, 0u, 0u, 0u};
        v4u pq[4], pk[4], pv; f32x4 po[2] = {(f32x4){0.f, 0.f, 0.f, 0.f}, (f32x4){0.f, 0.f, 0.f, 0.f}};
#define P3_LOAD(nn) do { const int r0_ = b * SEQ + (nn) * 64; \
            _Pragma("unroll") for (int i = 0; i < 4; ++i) { const int p = tid + 512 * i, row = p >> 5, pc = p & 31; \
                pq[i] = *(const v4u*)(Z + (size_t)(r0_ + row) * NZ + cq + pc * 8); pk[i] = *(const v4u*)(Z + (size_t)(r0_ + row) * NZ + ck + pc * 8); } \
            { const int s = tid >> 3, pc = tid & 7; pv = *(const v4u*)(Z + (size_t)(r0_ + s) * NZ + cv + pc * 8); } } while (0)
        P3_LOAD(0);
        for (int n = 0; n < 32; ++n) {
            const int r0 = b * SEQ + n * 64;
#pragma unroll
            for (int i = 0; i < 4; ++i) { const int p = tid + 512 * i, row = p >> 5, pc = p & 31;
                *(LAS v4u*)(lds + R_QS + row * QS_STR + pc * 16) = pq[i]; *(LAS v4u*)(lds + R_KS + row * QS_STR + pc * 16) = pk[i]; }
            { const int s = tid >> 3, pc = tid & 7; *(LAS v4u*)(lds + R_VT + s * VS_STR + pc * 16) = pv; }
            __syncthreads();
            const int dk = n < 16 ? n >> 3 : 2 + ((n - 16) >> 2), dms = n < 16 ? n & 7 : (n - 16) & 3, dnms = n < 16 ? 8 : 4; const bool dgla = n < 16;
            const int ddg = dgla ? (tid & 127) : (tid & 63), dcg = dgla ? (tid >> 7) : (tid >> 6), ddv = dgla ? 512 : 256, drpg = dgla ? 64 : 32;
            LAS float* dbuf = (LAS float*)(lds + R_DEC + (dk & 1) * 3072);
            if (n > 0) {
#pragma unroll
                for (int dj = 0; dj < 2; ++dj)
#pragma unroll
                    for (int e = 0; e < 4; ++e) O[(size_t)(r0 - 64 + (wave >> 1) * 16 + fq * 4 + e) * DM + ocol + (2 * (wave & 1) + dj) * 16 + fr] = po[dj][e];
                const int pdv = n <= 16 ? 512 : 256;
#pragma unroll
                for (int u = 0; u < 8; ++u) *(f32x4*)(dSoutPrev + (size_t)u * pdv) = dsv[u];
                if (dlastPrev) {
#pragma unroll
                    for (int e = 0; e < 4; ++e) atomicAdd(dOrow + e, doacc[e]);
                    doacc = (f32x4){0.f, 0.f, 0.f, 0.f}; }
            }
            if (dms == 0) {
                const int it = dgla ? vcu + 256 * dk : vcu + 256 * (dk - 2);
                const int db = dgla ? it >> 2 : it >> 3, dh = dgla ? it & 3 : it & 7, drow = MP + db;
                if (dgla) { const int c = dh * 256 + (tid & 255);
                    if (tid < 256) { float x = a.in[I_BGLA][c];
#pragma unroll
                        for (int j = 0; j < 16; ++j) x += RA[(size_t)drow * 16 + j] * a.in[I_WUP][j * 1024 + c];
                        dbuf[tid] = expf(log_sigmoid(x) * (1.f / 16.f)); dbuf[256 + tid] = slab_sum(ZS, NZ, db, ZQA + c) * 0.0625f; }
                    else dbuf[512 + tid - 256] = slab_sum(ZS, NZ, db, ZKA + c); }
                else if (tid < 256) { const int i = tid & 127, base = (tid < 128 ? ZQB : ZKB) + dh * 256 + i; const float sc = tid < 128 ? 1.0f : 0.0625f;
                    const float x1 = slab_sum(ZS, NZ, db, base), x2 = slab_sum(ZS, NZ, db, base + 128); const float cs = CT[i], sn = ST[i];
                    LAS float* dst = dbuf + (tid < 128 ? 256 : 512);
                    dst[i] = (x1 * cs - x2 * sn) * sc; dst[i + 128] = (x1 * sn + x2 * cs) * sc; }
                dv4 = slab_sum4(ZS, NZ, db, (dgla ? ZVA + dh * 512 : ZVB + dh * 256) + 4 * ddg);
                dgam = 1.0f - exp2f(-5.0f - (float)dh);
                const size_t sbase = (size_t)(db * (dgla ? 4 : 8) + dh) * 256 * ddv + 4 * ddg + (size_t)(dcg * drpg) * ddv;
                dSin = (dgla ? sgla : sret) + sbase; dSout = a.out + (dgla ? OUT_GLA_S : OUT_RET_S) + sbase;
                dOrow = (float*)(a.ws + (dgla ? WS_OA : WS_OB)) + (size_t)drow * DM + dh * ddv + 4 * ddg;
            }
            f32x4 dlv[2];
#pragma unroll
            for (int ci = 0; ci < 2; ++ci) { const int c0 = (2 * wave + ci) * 16 + fq * 4;
                const f32x4 ld = *(const f32x4*)(DL + (size_t)(b * 32 + n) * 1024 + (h & 3) * 256 + c0);
                dlv[ci] = gla ? ld : (f32x4){dret, dret, dret, dret}; }
#pragma unroll
            for (int u = 0; u < 8; ++u) dsv[u] = *(const f32x4*)(dSin + (size_t)(dms * 8 + u) * ddv);
            P3_LOAD(n + 1 < 32 ? n + 1 : 31);
            const int ti = wave >> 1, hp = wave & 1;
            f32x4 accA[2], accO[2];
#pragma unroll
            for (int j = 0; j < 2; ++j) { accA[j] = (f32x4){0.f, 0.f, 0.f, 0.f}; accO[j] = (f32x4){0.f, 0.f, 0.f, 0.f}; }
            const bool needA0 = (2 * hp) <= ti, needA1 = (2 * hp + 1) <= ti;
#define P3_QK_LOOP(NA) do { _Pragma("unroll") for (int kk = 0; kk < 8; ++kk) { const int kb = (kk * 32 + fq * 8) * 2; \
                const bf16x8 af = ldfrag(lds + R_QS + (ti * 16 + fr) * QS_STR + kb); \
                const bf16x8 s0 = ldfrag(lds + R_ST + ((2 * hp) * 16 + fr) * QS_STR + kb), s1 = ldfrag(lds + R_ST + ((2 * hp + 1) * 16 + fr) * QS_STR + kb); \
                accO[0] = __builtin_amdgcn_mfma_f32_16x16x32_bf16(af, s0, accO[0], 0, 0, 0); accO[1] = __builtin_amdgcn_mfma_f32_16x16x32_bf16(af, s1, accO[1], 0, 0, 0); \
                if (NA >= 1) { const bf16x8 k0f = ldfrag(lds + R_KS + ((2 * hp) * 16 + fr) * QS_STR + kb); accA[0] = __builtin_amdgcn_mfma_f32_16x16x32_bf16(af, k0f, accA[0], 0, 0, 0); } \
                if (NA >= 2) { const bf16x8 k1f = ldfrag(lds + R_KS + ((2 * hp + 1) * 16 + fr) * QS_STR + kb); accA[1] = __builtin_amdgcn_mfma_f32_16x16x32_bf16(af, k1f, accA[1], 0, 0, 0); } } } while (0)
            if (needA1) P3_QK_LOOP(2); else if (needA0) P3_QK_LOOP(1); else P3_QK_LOOP(0);
#pragma unroll
            for (int sj = 0; sj < 2; ++sj) { const int s = (2 * hp + sj) * 16 + fr;
#pragma unroll
                for (int e = 0; e < 4; ++e) { const int t = ti * 16 + fq * 4 + e; const float v = (s <= t) ? accA[sj][e] : 0.f;
                    *(LAS unsigned short*)(lds + R_AS + t * KT_STR + s * 2) = (unsigned short)f2bf(v); } }
            __syncthreads();
#pragma unroll
            for (int kk = 0; kk < 2; ++kk) if (kk * 32 <= ti * 16 + 15) { const int kb = (kk * 32 + fq * 8) * 2;
                const bf16x8 af = ldfrag(lds + R_AS + (ti * 16 + fr) * KT_STR + kb);
                const bf16x8 v0 = ld_tr_frag(lds + R_VT, VS_STR, kk, 2 * hp, lane), v1 = ld_tr_frag(lds + R_VT, VS_STR, kk, 2 * hp + 1, lane);
                accO[0] = __builtin_amdgcn_mfma_f32_16x16x32_bf16(af, v0, accO[0], 0, 0, 0); accO[1] = __builtin_amdgcn_mfma_f32_16x16x32_bf16(af, v1, accO[1], 0, 0, 0); }
            po[0] = accO[0]; po[1] = accO[1];
#pragma unroll
            for (int kk = 0; kk < 2; ++kk) { bf16x8 vf[4];
#pragma unroll
                for (int di = 0; di < 4; ++di) vf[di] = ld_tr_frag(lds + R_VT, VS_STR, kk, di, lane);
#pragma unroll
                for (int ci = 0; ci < 2; ++ci) { const bf16x8 af = ld_tr_frag(lds + R_KS, QS_STR, kk, 2 * wave + ci, lane);
#pragma unroll
                    for (int di = 0; di < 4; ++di) sacc[ci][di] = __builtin_amdgcn_mfma_f32_16x16x32_bf16(af, vf[di], sacc[ci][di], 0, 0, 0); } }
            __syncthreads();
#pragma unroll
            for (int ci = 0; ci < 2; ++ci) { const int c0 = (2 * wave + ci) * 16 + fq * 4; const f32x4 dl = dlv[ci];
#pragma unroll
                for (int di = 0; di < 4; ++di) { sacc[ci][di] = sacc[ci][di] * dl; const f32x4 v = sacc[ci][di];
                    v2u w; w.x = pk2(v[0], v[1]); w.y = pk2(v[2], v[3]);
                    *(LAS v2u*)(lds + R_ST + (di * 16 + fr) * QS_STR + c0 * 2) = w; } }
            {
                const int c0 = dcg * drpg + dms * 8;
                const f32x4 q0 = *(const LAS f32x4*)(dbuf + 256 + c0), q1 = *(const LAS f32x4*)(dbuf + 256 + c0 + 4), k0 = *(const LAS f32x4*)(dbuf + 512 + c0), k1 = *(const LAS f32x4*)(dbuf + 512 + c0 + 4);
                f32x4 a0 = (f32x4){dgam, dgam, dgam, dgam}, a1 = a0;
                if (dgla) { a0 = *(const LAS f32x4*)(dbuf + c0); a1 = *(const LAS f32x4*)(dbuf + c0 + 4); }
#pragma unroll
                for (int u = 0; u < 8; ++u) { const float au = u < 4 ? a0[u & 3] : a1[u & 3], ku = u < 4 ? k0[u & 3] : k1[u & 3], qu = u < 4 ? q0[u & 3] : q1[u & 3];
                    const f32x4 sn = dsv[u] * au + dv4 * ku; dsv[u] = sn; doacc += sn * qu; }
                dSoutPrev = dSout + (size_t)(dms * 8) * ddv; dlastPrev = (dms == dnms - 1);
            }
        }
#pragma unroll
        for (int dj = 0; dj < 2; ++dj)
#pragma unroll
            for (int e = 0; e < 4; ++e) O[(size_t)(b * SEQ + 31 * 64 + (wave >> 1) * 16 + fq * 4 + e) * DM + ocol + (2 * (wave & 1) + dj) * 16 + fr] = po[dj][e];
#pragma unroll
        for (int u = 0; u < 8; ++u) *(f32x4*)(dSoutPrev + (size_t)u * 256) = dsv[u];
#pragma unroll
        for (int e = 0; e < 4; ++e) atomicAdd(dOrow + e, doacc[e]);
        __syncthreads();
#undef P3_LOAD
#undef P3_QK_LOOP
        float* SO = a.out + (gla ? OUT_GLA_P : OUT_RET_P) + (size_t)(b * nh + h) * 256 * dv + ds * 64;
#pragma unroll
        for (int ci = 0; ci < 2; ++ci)
#pragma unroll
            for (int di = 0; di < 4; ++di)
#pragma unroll
                for (int e = 0; e < 4; ++e) SO[(size_t)((2 * wave + ci) * 16 + fq * 4 + e) * dv + di * 16 + fr] = sacc[ci][di][e];
    }
}

__device__ __forceinline__ void p3_decode(const Args& a, LAS unsigned char* lds, int vcu, int G, int tid) {
    unsigned char* ws = a.ws; const float* ZS = (const float*)(ws + WS_ZSLAB); const float* RA = (const float*)(ws + WS_RA); const float* CT = (const float*)(ws + WS_COS) + 2048 * 128; const float* ST = (const float*)(ws + WS_SIN) + 2048 * 128;
    const float* sgla = a.in[I_SGLA]; const float* sret = a.in[I_SRET];
    asm volatile("" : "+s"(sgla), "+s"(sret));
    LAS float* sa = (LAS float*)lds; LAS float* sq = sa + 256; LAS float* sk = sq + 256; LAS float* red = sk + 256;
    for (int item = vcu; item < 1536; item += G) {
        const bool gla = item < 512; const int it = gla ? item : item - 512;
        const int b = gla ? it >> 2 : it >> 3, h = gla ? it & 3 : it & 7, row = MP + b;
        __syncthreads();
        if (gla) { const int c = h * 256 + (tid & 255);
            if (tid < 256) { float x = a.in[I_BGLA][c];
#pragma unroll
                for (int j = 0; j < 16; ++j) x += RA[(size_t)row * 16 + j] * a.in[I_WUP][j * 1024 + c];
                sa[tid] = expf(log_sigmoid(x) * (1.f / 16.f)); sq[tid] = slab_sum(ZS, NZ, b, ZQA + c) * 0.0625f; }
            else sk[tid - 256] = slab_sum(ZS, NZ, b, ZKA + c); }
        else { const int wh = tid >> 7, i = tid & 127;
            red[tid] = slab_sum(ZS, NZ, b, (wh < 2 ? ZQB : ZKB) + h * 256 + (wh & 1) * 128 + i);
            __syncthreads();
            if (tid < 128) { const float cs = CT[i], sn = ST[i]; const float qa = red[i], qb = red[128 + i], ka = red[256 + i], kb = red[384 + i];
                sq[i] = qa * cs - qb * sn; sq[i + 128] = qa * sn + qb * cs; sk[i] = (ka * cs - kb * sn) * 0.0625f; sk[i + 128] = (ka * sn + kb * cs) * 0.0625f; } }
        __syncthreads();
        const int dv = gla ? 512 : 256, ngrp = gla ? 4 : 8, rows = gla ? 64 : 32, dg = gla ? (tid & 127) : (tid & 63), cg = gla ? (tid >> 7) : (tid >> 6);
        const float gam = 1.0f - exp2f(-5.0f - (float)h);
        const f32x4 v4 = slab_sum4(ZS, NZ, b, (gla ? ZVA + h * 512 : ZVB + h * 256) + 4 * dg);
        const size_t sbase = (size_t)(b * (gla ? 4 : 8) + h) * 256 * dv + 4 * dg;
        const float* Sin = (gla ? sgla : sret) + sbase; float* Sout = a.out + (gla ? OUT_GLA_S : OUT_RET_S) + sbase;
        f32x4 oacc = (f32x4){0.f, 0.f, 0.f, 0.f};
        for (int c0 = cg * rows; c0 < (cg + 1) * rows; c0 += 8) {
            f32x4 sv[8];
#pragma unroll
            for (int u = 0; u < 8; ++u) sv[u] = *(const f32x4*)(Sin + (size_t)(c0 + u) * dv);
#pragma unroll
            for (int u = 0; u < 8; ++u) { const int c = c0 + u; const float ac = gla ? sa[c] : gam; const f32x4 sn = sv[u] * ac + v4 * sk[c];
                *(f32x4*)(Sout + (size_t)c * dv) = sn; oacc += sn * sq[c]; }
        }
        __syncthreads();
        *(LAS f32x4*)(red + cg * 512 + 4 * dg) = oacc;
        __syncthreads();
        if (tid < dv / 4) { f32x4 s = (f32x4){0.f, 0.f, 0.f, 0.f};
            for (int g = 0; g < ngrp; ++g) s += *(LAS f32x4*)(red + g * 512 + 4 * tid);
            *(f32x4*)((float*)(ws + (gla ? WS_OA : WS_OB)) + (size_t)row * DM + h * dv + 4 * tid) = s; }
    }
    __syncthreads();
}

__device__ __forceinline__ void p4_merge(const Args& a, LAS unsigned char* lds, int vcu, int G, int gw, int NGW, int wave, int lane) {
    unsigned char* ws = a.ws; const bf16* Z = (const bf16*)(ws + WS_Z); const float* ZS = (const float*)(ws + WS_ZSLAB); const float* OA = (const float*)(ws + WS_OA); const float* OB = (const float*)(ws + WS_OB); bf16* MG = (bf16*)(ws + WS_MERGED);
    const float* gn = a.in[I_GNORM];
    for (int b = vcu; b < MS; b += G) { const int r = MP + b, col = 256 * wave + 4 * lane; LAS float* red = (LAS float*)lds;
        const f32x4 oa = *(const f32x4*)(OA + (size_t)r * DM + col), ob = *(const f32x4*)(OB + (size_t)r * DM + col);
        const f32x4 gav = slab_sum4(ZS, NZ, b, ZGA + col), gbv = slab_sum4(ZS, NZ, b, ZGB + col), mav = slab_sum4(ZS, NZ, b, ZMA + col), mbv = slab_sum4(ZS, NZ, b, ZMB + col);
        const float sa2 = wave_sum((oa.x * oa.x + oa.y * oa.y) + (oa.z * oa.z + oa.w * oa.w)), sb2 = wave_sum((ob.x * ob.x + ob.y * ob.y) + (ob.z * ob.z + ob.w * ob.w));
        __syncthreads(); if (lane == 0) red[wave] = sa2; __syncthreads();
        const float ra = rsqrtf((red[wave & ~1] + red[wave | 1]) * (1.f / 512.f) + EPS), rb = rsqrtf(sb2 * (1.f / 256.f) + EPS);
        const f32x4 gnv = *(const f32x4*)(gn + (col & 511)); float o[4];
#pragma unroll
        for (int e = 0; e < 4; ++e) { const float na = oa[e] * ra * gnv[e], nb = ob[e] * rb;
            o[e] = sigm(mav[e]) * (na * gav[e] * sigm(gav[e])) + sigm(mbv[e]) * (nb * gbv[e] * sigm(gbv[e])); }
        v2u w; w.x = pk2(o[0], o[1]); w.y = pk2(o[2], o[3]);
        *(v2u*)(MG + (size_t)r * DM + col) = w; }
    for (int r = gw; r < MP; r += NGW) {
        f32x4 oa[8], ob[8]; float sa2[8], sb2[8];
#pragma unroll
        for (int j = 0; j < 8; ++j) { oa[j] = *(const f32x4*)(OA + (size_t)r * DM + 256 * j + 4 * lane); ob[j] = *(const f32x4*)(OB + (size_t)r * DM + 256 * j + 4 * lane);
            sa2[j] = (oa[j].x * oa[j].x + oa[j].y * oa[j].y) + (oa[j].z * oa[j].z + oa[j].w * oa[j].w); sb2[j] = (ob[j].x * ob[j].x + ob[j].y * ob[j].y) + (ob[j].z * ob[j].z + ob[j].w * ob[j].w); }
        float ra[4], rb[8];
#pragma unroll
        for (int hh = 0; hh < 4; ++hh) ra[hh] = rsqrtf(wave_sum(sa2[2 * hh] + sa2[2 * hh + 1]) * (1.f / 512.f) + EPS);
#pragma unroll
        for (int hb = 0; hb < 8; ++hb) rb[hb] = rsqrtf(wave_sum(sb2[hb]) * (1.f / 256.f) + EPS);
        const bf16* zr = Z + (size_t)r * NZ;
#pragma unroll
        for (int j = 0; j < 8; ++j) { const int col = 256 * j + 4 * lane;
            const v2u ga = *(const v2u*)(zr + ZGA + col), gb = *(const v2u*)(zr + ZGB + col), ma = *(const v2u*)(zr + ZMA + col), mb = *(const v2u*)(zr + ZMB + col);
            const f32x4 gnv = *(const f32x4*)(gn + (col & 511));
            const float gav[4] = {bflo(ga.x), bfhi(ga.x), bflo(ga.y), bfhi(ga.y)}, gbv[4] = {bflo(gb.x), bfhi(gb.x), bflo(gb.y), bfhi(gb.y)};
            const float mav[4] = {bflo(ma.x), bfhi(ma.x), bflo(ma.y), bfhi(ma.y)}, mbv[4] = {bflo(mb.x), bfhi(mb.x), bflo(mb.y), bfhi(mb.y)};
            float o[4];
#pragma unroll
            for (int e = 0; e < 4; ++e) { const float na = oa[j][e] * ra[j >> 1] * gnv[e], nb = ob[j][e] * rb[j];
                o[e] = sigm(mav[e]) * (na * gav[e] * sigm(gav[e])) + sigm(mbv[e]) * (nb * gbv[e] * sigm(gbv[e])); }
            v2u w; w.x = pk2(o[0], o[1]); w.y = pk2(o[2], o[3]);
            *(v2u*)(MG + (size_t)r * DM + col) = w; }
    }
}
__device__ __forceinline__ float block_sum8(LAS float* red, float v, int wave, int lane) { v = wave_sum(v); __syncthreads(); if (lane == 0) red[wave] = v; __syncthreads();
    float s = 0.f;
#pragma unroll
    for (int w = 0; w < 8; ++w) s += red[w];
    return s; }
__device__ __forceinline__ void p6_norm_bf16(const Args& a, LAS unsigned char* lds, int vcu, int G, int gw, int NGW, int wave, int lane) {
    unsigned char* ws = a.ws; float* H = (float*)(ws + WS_H); const float* SL = (const float*)(ws + WS_SLAB2); bf16* HN = (bf16*)(ws + WS_HN); const float* g = a.in[I_NPLE];
    for (int b = vcu; b < MS; b += G) { const int r = MP + b, col = 256 * wave + 4 * lane;
        const f32x4 v = *(const f32x4*)(a.in[I_XS] + (size_t)b * DM + col) + slab_sum4(SL, DM, b, col);
        *(f32x4*)(H + (size_t)r * DM + col) = v;
        const float rs = rsqrtf(block_sum8((LAS float*)lds, (v.x * v.x + v.y * v.y) + (v.z * v.z + v.w * v.w), wave, lane) * (1.f / DM) + EPS);
        const f32x4 u = v * rs * *(const f32x4*)(g + col);
        *(unsigned long long*)(HN + (size_t)r * DM + col) = (unsigned long long)pk2(u.x, u.y) | ((unsigned long long)pk2(u.z, u.w) << 32); }
    for (int r = gw; r < MP; r += NGW) { const f32x4* x = (const f32x4*)(H + (size_t)r * DM) + lane; f32x4 v[8]; float s = 0.f;
#pragma unroll
        for (int j = 0; j < 8; ++j) { v[j] = x[64 * j]; s += (v[j].x * v[j].x + v[j].y * v[j].y) + (v[j].z * v[j].z + v[j].w * v[j].w); }
        const float rs = rsqrtf(wave_sum(s) * (1.f / DM) + EPS);
        unsigned long long* o = (unsigned long long*)(HN + (size_t)r * DM) + lane;
#pragma unroll
        for (int j = 0; j < 8; ++j) { const f32x4 gv = *((const f32x4*)g + lane + 64 * j); const f32x4 u = v[j] * rs * gv;
            o[64 * j] = (unsigned long long)pk2(u.x, u.y) | ((unsigned long long)pk2(u.z, u.w) << 32); } }
}
__device__ __forceinline__ void p8_norm_final(const Args& a, LAS unsigned char* lds, int vcu, int G, int gw, int NGW, int wave, int lane) {
    unsigned char* ws = a.ws; const float* H = (const float*)(ws + WS_H); const float* PPb = (const float*)(ws + WS_PP); const float* SL = (const float*)(ws + WS_SLAB2); const float* g = a.in[I_NFIN]; float* Y = a.out + OUT_Y;
    for (int b = vcu; b < MS; b += G) { const int r = MP + b, col = 256 * wave + 4 * lane;
        const f32x4 lg = slab_sum4(SL, DM, b, col), hv = *(const f32x4*)(H + (size_t)r * DM + col), pv = *(const f32x4*)(PPb + (size_t)r * DM + col); f32x4 v;
#pragma unroll
        for (int e = 0; e < 4; ++e) v[e] = hv[e] + pv[e] / (1.f + __expf(-lg[e]));
        const float rs = rsqrtf(block_sum8((LAS float*)lds, (v.x * v.x + v.y * v.y) + (v.z * v.z + v.w * v.w), wave, lane) * (1.f / DM) + EPS);
        *(f32x4*)(Y + (size_t)r * DM + col) = v * rs * *(const f32x4*)(g + col); }
    for (int r = gw; r < MP; r += NGW) { f32x4* x = (f32x4*)(Y + (size_t)r * DM) + lane; f32x4 v[8]; float s = 0.f;
#pragma unroll
        for (int j = 0; j < 8; ++j) { v[j] = x[64 * j]; s += (v[j].x * v[j].x + v[j].y * v[j].y) + (v[j].z * v[j].z + v[j].w * v[j].w); }
        const float rs = rsqrtf(wave_sum(s) * (1.f / DM) + EPS);
#pragma unroll
        for (int j = 0; j < 8; ++j) { const f32x4 gv = *((const f32x4*)g + lane + 64 * j); x[64 * j] = v[j] * rs * gv; } }
}
__global__ void __launch_bounds__(NWAVES * 64, 2) fwd_kernel(Args args) {
    extern __shared__ __attribute__((aligned(16))) unsigned char lds_raw[];
    LAS unsigned char* lds = (LAS unsigned char*)lds_raw;
    const int tid = threadIdx.x, lane = tid & 63, wave = __builtin_amdgcn_readfirstlane(tid >> 6);
    const int G = gridDim.x, bx = blockIdx.x;
    const int vcu = (G % 8 == 0) ? (bx % 8) * (G / 8) + bx / 8 : bx;
    const int gw = vcu * NWAVES + wave, NGW = G * NWAVES;
    volatile LAS unsigned* MISC = (volatile LAS unsigned*)(lds + MISC_OFF);
    if (tid < 64) MISC[tid] = 0u;
    __syncthreads();
    unsigned char* ws = args.ws;
    XcdBarrier bar; bar.bar = (unsigned*)(ws + WS_CTL) + CW_BAR; bar.x = 0; bar.st = nullptr;
    if (N_LAUNCHES == 1) bar = xcd_barrier_post((unsigned*)(ws + WS_CTL) + CW_BAR, MISC + 8);
    const int lo = args.ph_lo, hi = args.ph_hi;
#define IN(k) (lo <= (k) && (k) < hi)
#define SEAM(k) do { if (N_LAUNCHES == 1 && IN(k) && IN((k) + 1)) xcd_barrier(bar); } while (0)
    if (IN(0)) p0_rows(args, lds, gw, NGW, tid, lane);
    SEAM(0);
    if (IN(1)) p1_prep(args, lds, vcu, G, gw, NGW, tid, wave, lane);
    SEAM(1);
    if (IN(2)) {
        pg8::Gemm g{(const pg8::bf16_t*)(ws + WS_U), (const pg8::bf16_t*)(ws + WS_WIN), MPAD, NZ, DM}; pg8::SplitOrder S; S.init(MP / 256, NZ / 256, DM / 64, NSPLIT, 1, G, bx);
        pg8::EpiZ E{(pg8::bf16_t*)(ws + WS_Z), NZ, (float*)(ws + WS_ZSLAB), (const float*)(ws + WS_EB), (const float*)(ws + WS_COS), (const float*)(ws + WS_SIN)};
        pg8::gemm_phase<pg8::EpiZ, pg8::SplitOrder, true, true>(lds + RING_OFF, g, S, E);
    }
    SEAM(2);
    if (IN(3)) { if (G == 256) p3_fused(args, lds, vcu, tid, wave, lane); else { p3_recurrence(args, lds, vcu, G, tid, wave, lane); p3_decode(args, lds, vcu, G, tid); } }
    SEAM(3);
    if (IN(4)) p4_merge(args, lds, vcu, G, gw, NGW, wave, lane);
    SEAM(4);
    if (IN(5)) for (int rep = 0; rep < REP5; ++rep) {
        { pg8::Gemm g{(const pg8::bf16_t*)(ws + WS_MERGED), (const pg8::bf16_t*)(ws + WS_WOUT), MPAD, DM, DM}; pg8::SplitOrder S; S.init(MP / 256, DM / 256, DM / 64, NSPLIT, 1, G, bx);
          pg8::EpiResid E{args.in[I_XP], args.in[I_XS], (float*)(ws + WS_H), (float*)(ws + WS_SLAB2)};
          pg8::gemm_phase<pg8::EpiResid, pg8::SplitOrder, true, true>(lds + RING_OFF, g, S, E); }
        { pg8::Gemm g{(const pg8::bf16_t*)(ws + WS_PB), (const pg8::bf16_t*)(ws + WS_WPP), MPAD, DM, PLE}; pg8::SplitOrder S; S.init(MP / 256, DM / 256, PLE / 64, 1, 0, G, bx);
          pg8::EpiF32 E{(float*)(ws + WS_PP)};
          pg8::gemm_phase<pg8::EpiF32, pg8::SplitOrder, true, true>(lds + RING_OFF, g, S, E); }
    }
    SEAM(5);
    if (IN(6)) for (int rep = 0; rep < REP6; ++rep) p6_norm_bf16(args, lds, vcu, G, gw, NGW, wave, lane);
    SEAM(6);
    if (IN(7)) for (int rep = 0; rep < REP7; ++rep) {
        pg8::Gemm g{(const pg8::bf16_t*)(ws + WS_HN), (const pg8::bf16_t*)(ws + WS_WGATE), MPAD, DM, DM}; pg8::SplitOrder S; S.init(MP / 256, DM / 256, DM / 64, NSPLIT, 1, G, bx);
        pg8::EpiGate E{(const float*)(ws + WS_H), (const float*)(ws + WS_PP), args.out + OUT_Y, (float*)(ws + WS_SLAB2)};
        pg8::gemm_phase<pg8::EpiGate, pg8::SplitOrder, true, true>(lds + RING_OFF, g, S, E);
    }
    SEAM(7);
    if (IN(8)) p8_norm_final(args, lds, vcu, G, gw, NGW, wave, lane);
#undef IN
#undef SEAM
}

extern "C" void kernel_launch(void* const* d_in, const int* in_sizes, int n_in, void* d_out, int out_size, void* d_ws, size_t ws_size, hipStream_t stream) {
    static int grid = 0;
    if (grid == 0) {
        if (n_in != 16 || (size_t)out_size != OUT_END || ws_size < WS_END) { fprintf(stderr, "kernel_launch: unexpected shapes: n_in %d out %d ws %zu (need out %zu ws >= %zu); nothing launched\n", n_in, out_size, ws_size, (size_t)OUT_END, (size_t)WS_END); grid = -1; return; }
        int dev = 0, cus = 0, per_cu = 0;
        if (hipGetDevice(&dev) != hipSuccess || hipDeviceGetAttribute(&cus, hipDeviceAttributeMultiprocessorCount, dev) != hipSuccess) { fprintf(stderr, "kernel_launch: device query failed\n"); grid = -1; return; }
        if (hipFuncSetAttribute((const void*)fwd_kernel, hipFuncAttributeMaxDynamicSharedMemorySize, LDS_BYTES) != hipSuccess) { fprintf(stderr, "kernel_launch: hipFuncSetAttribute(%d B LDS) failed\n", LDS_BYTES); grid = -1; return; }
        if (hipOccupancyMaxActiveBlocksPerMultiprocessor(&per_cu, (const void*)fwd_kernel, NWAVES * 64, LDS_BYTES) != hipSuccess || per_cu < 1) { fprintf(stderr, "kernel_launch: occupancy query says %d blocks/CU; nothing launched\n", per_cu); (void)hipGetLastError(); grid = -1; return; }
        grid = cus;
    }
    if (grid < 0) return;
    if (hipMemsetAsync((char*)d_ws + WS_CTL, 0, CTL_ZERO_BYTES, stream) != hipSuccess) { fprintf(stderr, "kernel_launch: memset failed\n"); return; }
    Args a{};
    for (int i = 0; i < 16; ++i) a.in[i] = (const float*)d_in[i];
    a.out = (float*)d_out; a.ws = (unsigned char*)d_ws;
    if (PROBE_PHASE >= 0) { a.ph_lo = PROBE_PHASE; a.ph_hi = PROBE_PHASE + 1; a.li = 0; hipLaunchKernelGGL(fwd_kernel, dim3(grid), dim3(NWAVES * 64), LDS_BYTES, stream, a);
        (void)hipMemsetAsync((char*)d_ws + WS_CTL, 0, CTL_ZERO_BYTES, stream); }
    for (int li = 0; li < N_LAUNCHES; ++li) {
        a.ph_lo = (N_LAUNCHES == PER_PHASE) ? li : 0; a.ph_hi = (N_LAUNCHES == PER_PHASE) ? li + 1 : PER_PHASE; a.li = li;
        hipLaunchKernelGGL(fwd_kernel, dim3(grid), dim3(NWAVES * 64), LDS_BYTES, stream, a);
        const hipError_t le = hipPeekAtLastError();
        if (le != hipSuccess) { fprintf(stderr, "kernel_launch: launch %d failed: %s\n", li, hipGetErrorName(le)); break; }
    }
}
```
